# Optimizing an MI355X kernel written in HIP

```python
import jax, jax.numpy as jnp
from jax import lax
import numpy as np

D_MODEL = 1024
BATCH = 16
SEQ = 4096
DEPTH = 4

N_A_LAYERS = DEPTH // 2
N_B_LAYERS = DEPTH - N_A_LAYERS

CHUNK = 128
A_WIDTH = 2 * D_MODEL
A_GROUPS = 8
A_GROUP_CH = A_WIDTH // A_GROUPS

HEAD_DIM = 64
N_Q_HEADS = D_MODEL // HEAD_DIM
N_KV_HEADS = 4
Q_PER_KV = N_Q_HEADS // N_KV_HEADS
B_WIDTH = N_Q_HEADS * HEAD_DIM
KV_WIDTH = N_KV_HEADS * HEAD_DIM
WINDOW = 128
BLOCK = 128

EPS = 1e-6

kernel_name = "yoco_gmlp_swa_sink_hybrid"


def rms_norm(x, g):
    xf = x.astype(jnp.float32)
    y = xf * lax.rsqrt(jnp.mean(xf * xf, axis=-1, keepdims=True) + EPS)
    return (y * g.astype(jnp.float32)).astype(x.dtype)


def layer_norm(x, g, b):
    xf = x.astype(jnp.float32)
    mu = jnp.mean(xf, axis=-1, keepdims=True)
    var = jnp.mean(jnp.square(xf - mu), axis=-1, keepdims=True)
    y = (xf - mu) * lax.rsqrt(var + EPS)
    return (y * g.astype(jnp.float32) + b.astype(jnp.float32)).astype(x.dtype)


def alibi_slopes(n_heads):
    return jnp.asarray(np.array([2.0 ** (-8.0 * (h + 1) / n_heads) for h in range(n_heads)], dtype=np.float32))


def gmlp_mixer(h, w_in, ln_g, ln_b, w_s, b_s, w_out):
    bsz, s_len, _ = h.shape
    u, v, z = jnp.split(h @ w_in, 3, axis=-1)
    u = jax.nn.gelu(u)
    v = layer_norm(jax.nn.gelu(v), ln_g, ln_b)
    n_chunks = s_len // CHUNK
    v = v.reshape(bsz, n_chunks, CHUNK, A_GROUPS, A_GROUP_CH)
    causal = jnp.tril(jnp.ones((CHUNK, CHUNK), dtype=bool))
    w_causal = jnp.where(causal[None], w_s, 0.0).astype(v.dtype)
    s = jnp.einsum('gts,bnsgc->bntgc', w_causal, v) + b_s.T[:, :, None].astype(v.dtype)
    s = s.reshape(bsz, s_len, A_WIDTH)
    y = u * s * jax.nn.silu(z)
    return y @ w_out


def swa_mixer(h, k, v, w_in, sinks, w_out):
    bsz, s_len, _ = h.shape
    q, z = jnp.split(h @ w_in, 2, axis=-1)
    q = q * (HEAD_DIM ** -0.5)
    n_blocks = s_len // BLOCK
    q_blocks = q.reshape(bsz, n_blocks, BLOCK, N_KV_HEADS, Q_PER_KV, HEAD_DIM).transpose(1, 0, 2, 3, 4, 5)
    pad = jnp.zeros((bsz, BLOCK, N_KV_HEADS, HEAD_DIM), k.dtype)
    k_pad = jnp.concatenate([pad, k], axis=1)
    v_pad = jnp.concatenate([pad, v], axis=1)

    r = jnp.arange(BLOCK)[:, None]
    c = jnp.arange(2 * BLOCK)[None, :]
    dist = BLOCK + r - c
    in_window = (dist >= 0) & (dist < WINDOW)
    slopes = alibi_slopes(N_Q_HEADS).reshape(N_KV_HEADS, Q_PER_KV)
    alibi = -slopes[:, :, None, None] * dist.astype(jnp.float32)
    sink = sinks.astype(jnp.float32).reshape(N_KV_HEADS, Q_PER_KV)[None, :, :, None]

    def block_fn(args):
        i, qb = args
        start = i * BLOCK
        kb = lax.dynamic_slice_in_dim(k_pad, start, 2 * BLOCK, axis=1)
        vb = lax.dynamic_slice_in_dim(v_pad, start, 2 * BLOCK, axis=1)
        logits = jnp.einsum('btkgd,bskd->bkgts', qb, kb).astype(jnp.float32) + alibi
        valid = in_window & ((start - BLOCK + c) >= 0)
        logits = jnp.where(valid, logits, -jnp.inf)
        m = jnp.maximum(jnp.max(logits, axis=-1), sink)
        p = jnp.exp(logits - m[..., None])
        denom = jnp.sum(p, axis=-1) + jnp.exp(sink - m)
        o = jnp.einsum('bkgts,bskd->btkgd', p.astype(vb.dtype), vb).astype(jnp.float32)
        o = o / denom.transpose(0, 3, 1, 2)[..., None]
        return o.astype(h.dtype)

    out = lax.map(block_fn, (jnp.arange(n_blocks), q_blocks))
    out = out.transpose(1, 0, 2, 3, 4, 5).reshape(bsz, s_len, B_WIDTH)
    y = out * jax.nn.silu(z)
    return y @ w_out


def setup_inputs(seed: int = 0) -> dict:
    key = jax.random.key(seed)
    ks = jax.random.split(key, 20)
    f32 = jnp.float32
    nrm = lambda k, shape, scale: jax.random.normal(k, shape, f32) * scale
    x = jax.random.normal(ks[0], (BATCH, SEQ, D_MODEL), f32)
    a_w_in = nrm(ks[1], (N_A_LAYERS, D_MODEL, 3 * A_WIDTH), D_MODEL ** -0.5)
    a_ln_g = 1.0 + nrm(ks[2], (N_A_LAYERS, A_WIDTH), 0.05)
    a_ln_b = nrm(ks[3], (N_A_LAYERS, A_WIDTH), 0.02)
    a_w_s = nrm(ks[4], (N_A_LAYERS, A_GROUPS, CHUNK, CHUNK), CHUNK ** -0.5)
    a_b_s = 1.0 + nrm(ks[5], (N_A_LAYERS, A_GROUPS, CHUNK), 0.1)
    a_w_out = nrm(ks[6], (N_A_LAYERS, A_WIDTH, D_MODEL), A_WIDTH ** -0.5)
    a_pre_g = 1.0 + nrm(ks[7], (N_A_LAYERS, D_MODEL), 0.05)
    a_post_g = 1.0 + nrm(ks[8], (N_A_LAYERS, D_MODEL), 0.05)
    kv_norm_g = 1.0 + nrm(ks[9], (D_MODEL,), 0.05)
    w_k = nrm(ks[10], (D_MODEL, KV_WIDTH), D_MODEL ** -0.5)
    w_v = nrm(ks[11], (D_MODEL, KV_WIDTH), D_MODEL ** -0.5)
    b_w_in = nrm(ks[12], (N_B_LAYERS, D_MODEL, 2 * B_WIDTH), D_MODEL ** -0.5)
    b_sinks = nrm(ks[13], (N_B_LAYERS, N_Q_HEADS), 0.5)
    b_w_out = nrm(ks[14], (N_B_LAYERS, B_WIDTH, D_MODEL), B_WIDTH ** -0.5)
    b_pre_g = 1.0 + nrm(ks[15], (N_B_LAYERS, D_MODEL), 0.05)
    b_post_g = 1.0 + nrm(ks[16], (N_B_LAYERS, D_MODEL), 0.05)
    return {"x": x, "a_w_in": a_w_in, "a_ln_g": a_ln_g, "a_ln_b": a_ln_b, "a_w_s": a_w_s,
            "a_b_s": a_b_s, "a_w_out": a_w_out, "a_pre_g": a_pre_g, "a_post_g": a_post_g,
            "kv_norm_g": kv_norm_g, "w_k": w_k, "w_v": w_v, "b_w_in": b_w_in, "b_sinks": b_sinks,
            "b_w_out": b_w_out, "b_pre_g": b_pre_g, "b_post_g": b_post_g}


def reference(x, a_w_in, a_ln_g, a_ln_b, a_w_s, a_b_s, a_w_out, a_pre_g, a_post_g,
              kv_norm_g, w_k, w_v, b_w_in, b_sinks, b_w_out, b_pre_g, b_post_g):
    bsz, s_len, _ = x.shape
    h = x
    k_shared = None
    v_shared = None
    for layer in range(DEPTH):
        if layer < N_A_LAYERS:
            i = layer
            y = gmlp_mixer(rms_norm(h, a_pre_g[i]), a_w_in[i], a_ln_g[i], a_ln_b[i],
                           a_w_s[i], a_b_s[i], a_w_out[i])
            h = h + rms_norm(y, a_post_g[i])
            if layer == N_A_LAYERS - 1:
                kv_in = rms_norm(h, kv_norm_g)
                k_shared = (kv_in @ w_k).reshape(bsz, s_len, N_KV_HEADS, HEAD_DIM)
                v_shared = (kv_in @ w_v).reshape(bsz, s_len, N_KV_HEADS, HEAD_DIM)
        else:
            j = layer - N_A_LAYERS
            y = swa_mixer(rms_norm(h, b_pre_g[j]), k_shared, v_shared,
                          b_w_in[j], b_sinks[j], b_w_out[j])
            h = h + rms_norm(y, b_post_g[j])
    return h
```

```cpp
#include <hip/hip_runtime.h>
#include <hip/hip_cooperative_groups.h>
#include <cstdio>
#include <cstdint>
namespace cg = cooperative_groups;
namespace pg8 {
#define PG8_LAS __attribute__((address_space(3)))
typedef unsigned short bf16_t;
typedef short bf16x8 __attribute__((ext_vector_type(8)));
typedef float f32x4 __attribute__((ext_vector_type(4)));
typedef unsigned u32x4 __attribute__((ext_vector_type(4)));
constexpr int BM = 256, BK = 64, HALF = 128, HTB = HALF * BK * 2  , STAGE_BYTES = 8 * HTB, NXCD = 8, WGM = 8;

__host__ __device__ __forceinline__ int lds_byte(int r, int c) { const int st = (r >> 4) * 2 + (c >> 5), rr = r & 15, cc = c & 31, ob = rr * 64 + cc * 2; return st * 1024 + (ob ^ (((ob >> 9) & 1) << 5)); }
__host__ __device__ __forceinline__ void stage_rc(int b, int& R, int& C) { const int st = b / 1024, sb = b % 1024, swz = sb ^ (((sb >> 9) & 1) << 5); R = (st >> 1) * 16 + swz / 64; C = (st & 1) * 32 + (swz % 64) / 2; }
__host__ __device__ __forceinline__ int perm32(int rho) { const int n = rho >> 4, i = rho & 15; return 8 * (i >> 2) + 4 * n + (i & 3); }

struct Unit { int pm, pn; };
struct Gemm { const bf16_t* A; const bf16_t* Bt; int M, N, K; };

struct StaticOrder {
    int nM, nN, nwg, G, c;
    __host__ __device__ void init(int M, int N, int G_, int c_) { nM = M / BM; nN = N / BM; nwg = nM * nN; G = G_; c = c_; }
    __host__ __device__ bool next(int i, Unit& u) const {
        const long L = (long)i * G + c; if (L >= nwg) return false;
        int wgid = (int)L; { const int q = nwg / NXCD, r = nwg % NXCD, xcd = wgid % NXCD, off = wgid / NXCD; wgid = (xcd < r ? xcd * (q + 1) : r * (q + 1) + (xcd - r) * q) + off; }
        const int nig = WGM * nN, gid = wgid / nig, fm = gid * WGM, gsz = (nM - fm) < WGM ? (nM - fm) : WGM;
        u.pm = fm + ((wgid % nig) % gsz); u.pn = (wgid % nig) / gsz; return true;
    }
    __device__ __forceinline__ void a_ready(const Unit&) const {}
    __device__ __forceinline__ void done(const Unit&) const {}
};
__device__ __forceinline__ unsigned cvt_pk_bf16(float lo, float hi) { unsigned r; asm volatile("v_cvt_pk_bf16_f32 %0, %1, %2" : "=v"(r) : "v"(lo), "v"(hi)); return r; }
typedef float f32x2 __attribute__((ext_vector_type(2)));
template <class Epi, class Sched, bool ALIGN_EPI = false, bool SP2 = false>
__device__ __forceinline__ void gemm_phase(PG8_LAS unsigned char* lds, const Gemm g, const Sched& S, const Epi& E) {
    int tid_l = threadIdx.x; asm volatile("" : "+v"(tid_l));
    const int tid = tid_l, wid = __builtin_amdgcn_readfirstlane(tid >> 6), lane = tid & 63, wr = wid >> 2, wc = wid & 3, fr = lane & 15, fq = lane >> 4;
    const int K = g.K, nt = K / BK;
    unsigned voffA[2], voffB[2];
#pragma unroll
    for (int i = 0; i < 2; ++i) { int R, C; stage_rc(tid * 16 + i * 8192, R, C); const int Rb = Epi::PERM ? ((R & ~31) + perm32(R & 31)) : R;
        voffA[i] = (unsigned)(R * K + C) * 2u; voffB[i] = (unsigned)(Rb * K + C) * 2u; }
    const size_t kstep = (size_t)(BK * 2);
    const size_t hstep = (size_t)HALF * K * 2;
    const size_t tstep = 2 * hstep;
    const unsigned ldsw = (unsigned)wid * 1024u;
    const int aoff = lds_byte(wr * 64 + fr, fq * 8), boff = lds_byte(wc * 32 + fr, fq * 8);
#define PG8_SA(b, h) (((b) * 2 + (h)) * HTB)
#define PG8_SB(b, h) ((4 + (b) * 2 + (h)) * HTB)
#define PG8_STAGE(bufoff, gbase, voff) do { _Pragma("unroll") for (int _i = 0; _i < 2; ++_i) \
        __builtin_amdgcn_global_load_lds((const unsigned*)((const char*)(gbase) + (voff)[_i]), (PG8_LAS unsigned*)(lds + (bufoff) + ldsw + _i * 8192), 16, 0, 0); } while (0)
#define PG8_LDA(dst, b, h) do { _Pragma("unroll") for (int m = 0; m < 4; ++m) _Pragma("unroll") for (int k = 0; k < 2; ++k) dst[m][k] = *(const PG8_LAS bf16x8*)(lds + PG8_SA(b, h) + aoff + m * 2048 + k * 1024); } while (0)
#define PG8_LDB(dst, b, h) do { _Pragma("unroll") for (int n = 0; n < 2; ++n) _Pragma("unroll") for (int k = 0; k < 2; ++k) dst[n][k] = *(const PG8_LAS bf16x8*)(lds + PG8_SB(b, h) + boff + n * 2048 + k * 1024); } while (0)
#define PG8_MMA(ai, bj, At, Bt) do { __builtin_amdgcn_s_setprio(1); _Pragma("unroll") for (int m = 0; m < 4; ++m) _Pragma("unroll") for (int n = 0; n < 2; ++n) _Pragma("unroll") for (int k = 0; k < 2; ++k) \
        acc[ai][bj][m][n] = __builtin_amdgcn_mfma_f32_16x16x32_bf16(Bt[n][k], At[m][k], acc[ai][bj][m][n], 0, 0, 0); __builtin_amdgcn_s_setprio(0); } while (0)
#define PG8_WAIT_V(n) asm volatile("s_waitcnt vmcnt(" #n ")" ::: "memory")
#define PG8_WAIT_L(n) asm volatile("s_waitcnt lgkmcnt(" #n ")" ::: "memory")
#define PG8_BAR __builtin_amdgcn_s_barrier()
#define PG8_SCHED __builtin_amdgcn_sched_barrier(0)
    Unit cur, nxt; int ui = 0;
    if (!S.next(0, cur)) return;
    f32x4 acc[2][2][4][2];
#pragma unroll
    for (int a = 0; a < 2; ++a)
#pragma unroll
        for (int b = 0; b < 2; ++b)
#pragma unroll
            for (int m = 0; m < 4; ++m)
#pragma unroll
                for (int n = 0; n < 2; ++n) acc[a][b][m][n] = (f32x4){0.f, 0.f, 0.f, 0.f};
    bf16x8 At[4][2], B0[2][2], B1[2][2];
    const char* cA = (const char*)g.A + (size_t)cur.pm * tstep; const char* cB = (const char*)g.Bt + (size_t)cur.pn * tstep;
    S.a_ready(cur);
    if constexpr (SP2) {
        PG8_STAGE(PG8_SB(0, 0), cB, voffB); PG8_STAGE(PG8_SB(0, 1), cB + hstep, voffB); PG8_STAGE(PG8_SA(0, 0), cA, voffA); PG8_STAGE(PG8_SA(0, 1), cA + hstep, voffA);
        if (wr == 1) PG8_BAR;
        PG8_WAIT_V(2); PG8_BAR;
        PG8_STAGE(PG8_SB(1, 0), cB + kstep, voffB); PG8_STAGE(PG8_SA(1, 0), cA + kstep, voffA); PG8_STAGE(PG8_SB(1, 1), cB + hstep + kstep, voffB);
        PG8_WAIT_V(6); PG8_BAR;
    } else {
        PG8_STAGE(PG8_SB(0, 0), cB, voffB); PG8_STAGE(PG8_SA(0, 0), cA, voffA); PG8_STAGE(PG8_SB(0, 1), cB + hstep, voffB); PG8_STAGE(PG8_SA(0, 1), cA + hstep, voffA);
        if (wr == 1) PG8_BAR;
        PG8_WAIT_V(4); PG8_BAR;
        PG8_STAGE(PG8_SB(1, 0), cB + kstep, voffB); PG8_STAGE(PG8_SA(1, 0), cA + kstep, voffA); PG8_STAGE(PG8_SB(1, 1), cB + hstep + kstep, voffB);
        PG8_WAIT_V(6); PG8_BAR;
    }
    for (;;) {
        const bool has_next = S.next(ui + 1, nxt);
        const char* nA = has_next ? (const char*)g.A + (size_t)nxt.pm * tstep : cA; const char* nB = has_next ? (const char*)g.Bt + (size_t)nxt.pn * tstep : cB;
        for (int t = 0; t < nt; t += 2) {
            const bool last = (t == nt - 2);
            const char* a1 = cA + (size_t)(t + 1) * kstep;
            const char* a2 = last ? nA : cA + (size_t)(t + 2) * kstep; const char* b2 = last ? nB : cB + (size_t)(t + 2) * kstep;
            const char* a3 = a2 + kstep; const char* b3 = b2 + kstep;
            if (last && has_next) S.a_ready(nxt);
            if constexpr (SP2) {
            PG8_LDB(B0, 0, 0); PG8_LDB(B1, 0, 1); PG8_SCHED; PG8_LDA(At, 0, 0); PG8_STAGE(PG8_SA(1, 1), a1 + hstep, voffA);
            PG8_WAIT_V(8); PG8_WAIT_L(0); PG8_BAR; PG8_MMA(0, 0, At, B0); PG8_MMA(0, 1, At, B1); PG8_BAR; PG8_SCHED;
            PG8_LDA(At, 0, 1); PG8_STAGE(PG8_SB(0, 0), b2, voffB); PG8_STAGE(PG8_SB(0, 1), b2 + hstep, voffB); PG8_STAGE(PG8_SA(0, 0), a2, voffA);
            PG8_WAIT_V(8); PG8_WAIT_L(0); PG8_BAR; PG8_MMA(1, 0, At, B0); PG8_MMA(1, 1, At, B1); PG8_BAR; PG8_SCHED;
            PG8_LDB(B0, 1, 0); PG8_LDB(B1, 1, 1); PG8_SCHED; PG8_LDA(At, 1, 0); PG8_STAGE(PG8_SA(0, 1), a2 + hstep, voffA);
            PG8_WAIT_V(8); PG8_WAIT_L(0); PG8_BAR; PG8_MMA(0, 0, At, B0); PG8_MMA(0, 1, At, B1); PG8_BAR; PG8_SCHED;
            PG8_LDA(At, 1, 1); PG8_STAGE(PG8_SB(1, 0), b3, voffB); PG8_STAGE(PG8_SB(1, 1), b3 + hstep, voffB); PG8_STAGE(PG8_SA(1, 0), a3, voffA);
            PG8_WAIT_V(8); PG8_WAIT_L(0); PG8_BAR; PG8_MMA(1, 0, At, B0); PG8_MMA(1, 1, At, B1); PG8_BAR; PG8_SCHED;
            } else {
            PG8_LDB(B0, 0, 0); PG8_SCHED; PG8_LDA(At, 0, 0); PG8_STAGE(PG8_SA(1, 1), a1 + hstep, voffA);
            PG8_WAIT_L(8); PG8_BAR; PG8_WAIT_L(0); PG8_MMA(0, 0, At, B0); PG8_BAR; PG8_SCHED;
            PG8_LDB(B1, 0, 1); PG8_STAGE(PG8_SB(0, 0), b2, voffB);
            PG8_BAR; PG8_WAIT_L(0); PG8_MMA(0, 1, At, B1); PG8_BAR;
            PG8_LDA(At, 0, 1); PG8_STAGE(PG8_SA(0, 0), a2, voffA);
            PG8_BAR; PG8_WAIT_L(0); PG8_MMA(1, 0, At, B0); PG8_BAR; PG8_SCHED;
            PG8_STAGE(PG8_SB(0, 1), b2 + hstep, voffB);
            PG8_WAIT_V(6); PG8_BAR; PG8_MMA(1, 1, At, B1); PG8_BAR;
            PG8_LDB(B0, 1, 0); PG8_SCHED; PG8_LDA(At, 1, 0); PG8_STAGE(PG8_SA(0, 1), a2 + hstep, voffA);
            PG8_WAIT_L(8); PG8_BAR; PG8_WAIT_L(0); PG8_MMA(0, 0, At, B0); PG8_BAR; PG8_SCHED;
            PG8_LDB(B1, 1, 1); PG8_STAGE(PG8_SB(1, 0), b3, voffB);
            PG8_BAR; PG8_WAIT_L(0); PG8_MMA(0, 1, At, B1); PG8_BAR;
            PG8_LDA(At, 1, 1); PG8_STAGE(PG8_SA(1, 0), a3, voffA);
            PG8_BAR; PG8_WAIT_L(0); PG8_MMA(1, 0, At, B0); PG8_BAR; PG8_SCHED;
            PG8_STAGE(PG8_SB(1, 1), b3 + hstep, voffB);
            PG8_WAIT_V(6); PG8_BAR; PG8_MMA(1, 1, At, B1); PG8_BAR;
            }
        }
        if constexpr (ALIGN_EPI) { if (wr == 0) PG8_BAR; }
        if constexpr (!Epi::AFTER_DRAIN) { E(acc, cur, wr, wc, fr, fq); S.done(cur); }
        if (!has_next) break;
#pragma unroll
        for (int a = 0; a < 2; ++a)
#pragma unroll
            for (int b = 0; b < 2; ++b)
#pragma unroll
                for (int m = 0; m < 4; ++m)
#pragma unroll
                    for (int n = 0; n < 2; ++n) acc[a][b][m][n] = (f32x4){0.f, 0.f, 0.f, 0.f};
        cur = nxt; cA = nA; cB = nB; ++ui;
        if constexpr (ALIGN_EPI) { if (wr == 1) PG8_BAR; }
    }
    PG8_WAIT_V(0);
    if constexpr (!ALIGN_EPI) { if (wr == 0) PG8_BAR; }
    PG8_BAR;
    if constexpr (Epi::AFTER_DRAIN) { E.fused(acc, cur, wr, wc, fr, fq, lds, wid, lane); S.done(cur); }
#undef PG8_SA
#undef PG8_SB
#undef PG8_STAGE
#undef PG8_LDA
#undef PG8_LDB
#undef PG8_MMA
#undef PG8_WAIT_V
#undef PG8_WAIT_L
#undef PG8_BAR
#undef PG8_SCHED
}
}


constexpr int NWAVES = 8;
constexpr int M = 65536, D = 1024, AW = 2048, SEQ = 4096, CH = 128;
constexpr float EPS = 1e-6f;
constexpr size_t MiB = 1u << 20;
constexpr size_t WS_WA_IN = 1 * MiB;
constexpr size_t WS_WA_OUT = 25 * MiB;
constexpr size_t WS_WB_IN0 = 33 * MiB;
constexpr size_t WS_WB_IN1 = 38 * MiB;
constexpr size_t WS_WB_OUT = 42 * MiB;
constexpr size_t WS_STAT = 46 * MiB;
constexpr size_t WS_HN = 64 * MiB;
constexpr size_t WS_U = 192 * MiB;
constexpr size_t WS_VT = 448 * MiB;
constexpr size_t WS_Z = 704 * MiB;
constexpr size_t WS_END = 960 * MiB;
constexpr int LDS_BYTES = 131072 + 2048;

#define LAS __attribute__((address_space(3)))
typedef unsigned short bf16;
typedef unsigned v4u __attribute__((ext_vector_type(4)));
typedef unsigned v2u __attribute__((ext_vector_type(2)));
typedef float f32x4 __attribute__((ext_vector_type(4)));
typedef short bf16x8 __attribute__((ext_vector_type(8)));
typedef short bf16x4 __attribute__((ext_vector_type(4)));

__device__ __forceinline__ unsigned f2bf(float f) { unsigned u = __builtin_bit_cast(unsigned, f); return (u + 0x7fffu + ((u >> 16) & 1u)) >> 16; }
__device__ __forceinline__ unsigned pk2(float lo, float hi) { return pg8::cvt_pk_bf16(lo, hi); }
__device__ __forceinline__ float bflo(unsigned w) { return __builtin_bit_cast(float, w << 16); }
__device__ __forceinline__ float bfhi(unsigned w) { return __builtin_bit_cast(float, w & 0xffff0000u); }
__device__ __forceinline__ float wave_sum(float v) {
#pragma unroll
    for (int o = 1; o < 64; o <<= 1) v += __shfl_xor(v, o);
    return v;
}
__device__ __forceinline__ float act_sig(float x, float c1n, float c3n) {
    const float t = x * (c1n + c3n * x * x);
    return x * __builtin_amdgcn_rcpf(1.0f + __builtin_amdgcn_exp2f(t));
}
constexpr float LOG2E = 1.4426950408889634f;
constexpr float GELU_C1N = -1.5957691216057308f * LOG2E, GELU_C3N = -0.07135481627f * LOG2E, SILU_C1N = -LOG2E;

namespace pg8 {
struct EpiUZ {
    static constexpr bool PERM = true, AFTER_DRAIN = false;
    bf16_t* U; bf16_t* Z;
    __device__ __forceinline__ void operator()(const f32x4 (&acc)[2][2][4][2], const Unit& u, int wr, int wc, int fr, int fq) const {
        const bool isz = u.pn >= 8; bf16_t* base = isz ? Z : U;
        const float c1 = isz ? SILU_C1N : GELU_C1N, c3 = isz ? 0.f : GELU_C3N;
        const int row0 = u.pm * BM + wr * 64 + fr, col0 = (u.pn & 7) * BM + wc * 32 + 8 * fq;
#pragma unroll
        for (int ai = 0; ai < 2; ++ai)
#pragma unroll
            for (int m = 0; m < 4; ++m) { bf16_t* rowp = base + (size_t)(row0 + ai * HALF + m * 16) * AW + col0;
#pragma unroll
                for (int bj = 0; bj < 2; ++bj) { const f32x4 v0 = acc[ai][bj][m][0], v1 = acc[ai][bj][m][1]; u32x4 w;
                    w.x = cvt_pk_bf16(act_sig(v0[0], c1, c3), act_sig(v0[1], c1, c3)); w.y = cvt_pk_bf16(act_sig(v0[2], c1, c3), act_sig(v0[3], c1, c3));
                    w.z = cvt_pk_bf16(act_sig(v1[0], c1, c3), act_sig(v1[1], c1, c3)); w.w = cvt_pk_bf16(act_sig(v1[2], c1, c3), act_sig(v1[3], c1, c3));
                    *(u32x4*)(rowp + bj * HALF) = w; } }
    }
};
template <bool GELU> struct EpiT {
    static constexpr bool PERM = true, AFTER_DRAIN = false;
    bf16_t* OT; float* ssum; float* ssq;
    __device__ __forceinline__ void operator()(const f32x4 (&acc)[2][2][4][2], const Unit& u, int wr, int wc, int fr, int fq) const {
        const int row0 = u.pm * BM + wr * 64 + fr, col0 = u.pn * BM + wc * 32 + 8 * fq;
        f32x4 s[2][2], q[2][2];
#pragma unroll
        for (int bj = 0; bj < 2; ++bj)
#pragma unroll
            for (int n = 0; n < 2; ++n) { s[bj][n] = (f32x4){0.f, 0.f, 0.f, 0.f}; q[bj][n] = (f32x4){0.f, 0.f, 0.f, 0.f}; }
#pragma unroll
        for (int ai = 0; ai < 2; ++ai)
#pragma unroll
            for (int m = 0; m < 4; ++m) { bf16_t* rowp = OT + (size_t)(row0 + ai * HALF + m * 16) * M + col0;
#pragma unroll
                for (int bj = 0; bj < 2; ++bj) { f32x4 v0 = acc[ai][bj][m][0], v1 = acc[ai][bj][m][1];
                    if (GELU) {
#pragma unroll
                        for (int j = 0; j < 4; ++j) { v0[j] = act_sig(v0[j], GELU_C1N, GELU_C3N); v1[j] = act_sig(v1[j], GELU_C1N, GELU_C3N); }
                        s[bj][0] += v0; s[bj][1] += v1; q[bj][0] += v0 * v0; q[bj][1] += v1 * v1; }
                    u32x4 w; w.x = cvt_pk_bf16(v0[0], v0[1]); w.y = cvt_pk_bf16(v0[2], v0[3]); w.z = cvt_pk_bf16(v1[0], v1[1]); w.w = cvt_pk_bf16(v1[2], v1[3]);
                    *(u32x4*)(rowp + bj * HALF) = w; } }
        if (GELU) {
#pragma unroll
            for (int bj = 0; bj < 2; ++bj)
#pragma unroll
                for (int n = 0; n < 2; ++n)
#pragma unroll
                    for (int j = 0; j < 4; ++j) {
#pragma unroll
                        for (int o = 1; o < 16; o <<= 1) { s[bj][n][j] += __shfl_xor(s[bj][n][j], o); q[bj][n][j] += __shfl_xor(q[bj][n][j], o); } }
            if (fr == 0) { const size_t slot = (size_t)(u.pm * 2 + wr) * M + col0;
#pragma unroll
                for (int bj = 0; bj < 2; ++bj)
#pragma unroll
                    for (int n = 0; n < 2; ++n) { *(f32x4*)(ssum + slot + bj * HALF + 4 * n) = s[bj][n]; *(f32x4*)(ssq + slot + bj * HALF + 4 * n) = q[bj][n]; } }
        }
    }
};
struct EpiBin {
    static constexpr bool PERM = true, AFTER_DRAIN = false;
    unsigned char* ws;
    __device__ __forceinline__ void operator()(const f32x4 (&acc)[2][2][4][2], const Unit& u, int wr, int wc, int fr, int fq) const {
        const bool isz = (u.pn >= 4) && (u.pn < 8); const bool isk = u.pn >= 8;
        const size_t boff = isk ? (size_t)(WS_Z) : (isz ? (size_t)(WS_U + (size_t)M * D * 2) : (size_t)WS_U);
        bf16_t* base = (bf16_t*)(ws + boff); const int ldc = isk ? 256 : 1024;
        const int row0 = u.pm * BM + wr * 64 + fr, col0 = (isk ? 0 : (u.pn & 3) * BM) + wc * 32 + 8 * fq;
#pragma unroll
        for (int ai = 0; ai < 2; ++ai)
#pragma unroll
            for (int m = 0; m < 4; ++m) { bf16_t* rowp = base + (size_t)(row0 + ai * HALF + m * 16) * ldc + col0;
#pragma unroll
                for (int bj = 0; bj < 2; ++bj) { f32x4 v0 = acc[ai][bj][m][0], v1 = acc[ai][bj][m][1];
                    if (isz) { v0 = (f32x4){act_sig(v0.x, SILU_C1N, 0.f), act_sig(v0.y, SILU_C1N, 0.f), act_sig(v0.z, SILU_C1N, 0.f), act_sig(v0.w, SILU_C1N, 0.f)};
                        v1 = (f32x4){act_sig(v1.x, SILU_C1N, 0.f), act_sig(v1.y, SILU_C1N, 0.f), act_sig(v1.z, SILU_C1N, 0.f), act_sig(v1.w, SILU_C1N, 0.f)}; }
                    u32x4 w; w.x = cvt_pk_bf16(v0[0], v0[1]); w.y = cvt_pk_bf16(v0[2], v0[3]); w.z = cvt_pk_bf16(v1[0], v1[1]); w.w = cvt_pk_bf16(v1[2], v1[3]);
                    *(u32x4*)(rowp + bj * HALF) = w; } }
    }
};
struct EpiF32 {
    static constexpr bool PERM = false, AFTER_DRAIN = false;
    float* C; int ldc;
    __device__ __forceinline__ void operator()(const f32x4 (&acc)[2][2][4][2], const Unit& u, int wr, int wc, int fr, int fq) const {
        const int row0 = u.pm * BM + wr * 64 + fr, col0 = u.pn * BM + wc * 32 + 4 * fq;
#pragma unroll
        for (int ai = 0; ai < 2; ++ai)
#pragma unroll
            for (int m = 0; m < 4; ++m) { float* rowp = C + (size_t)(row0 + ai * HALF + m * 16) * ldc + col0;
#pragma unroll
                for (int bj = 0; bj < 2; ++bj)
#pragma unroll
                    for (int n = 0; n < 2; ++n) *(f32x4*)(rowp + bj * HALF + n * 16) = acc[ai][bj][m][n]; }
    }
};
}

struct Args {
    const float* x; const float* a_w_in; const float* a_ln_g; const float* a_ln_b; const float* a_w_s; const float* a_b_s; const float* a_w_out;
    const float* a_pre_g; const float* a_post_g; const float* kv_norm_g; const float* w_k; const float* w_v; const float* b_w_in; const float* b_sinks;
    const float* b_w_out; const float* b_pre_g; const float* b_post_g;
    float* out; unsigned char* ws;
};

__device__ __forceinline__ void transpose_item(const float* W, int ldw, int col0, int K, bf16* WT, int row_off, int nblk, const float* gv, float mult, LAS float* scr, int item, int lane) {
    const int kb = item / nblk, nb = item % nblk, k0 = 64 * kb, n0 = 32 * nb;
#pragma unroll 8
    for (int i = 0; i < 32; ++i) { const int kk = 2 * i + (lane >> 5); const float g = gv ? gv[k0 + kk] * mult : mult;
        scr[kk * 33 + (lane & 31)] = W[(size_t)(k0 + kk) * ldw + col0 + n0 + (lane & 31)] * g; }
    asm volatile("s_waitcnt lgkmcnt(0)" ::: "memory");
    const int c = lane & 7;
#pragma unroll
    for (int j = 0; j < 4; ++j) { const int n = (lane >> 3) + 8 * j; const LAS float* s = scr + (8 * c) * 33 + n;
        v4u o; o.x = pk2(s[0 * 33], s[1 * 33]); o.y = pk2(s[2 * 33], s[3 * 33]); o.z = pk2(s[4 * 33], s[5 * 33]); o.w = pk2(s[6 * 33], s[7 * 33]);
        *(v4u*)(WT + (size_t)(row_off + n0 + n) * K + k0 + 8 * c) = o; }
    asm volatile("s_waitcnt lgkmcnt(0)" ::: "memory");
}

__device__ __forceinline__ void p0_prologue(const Args& a, LAS unsigned char* lds, int gw, int NGW, int wave, int lane) {
    LAS float* scr = (LAS float*)(lds + wave * 16384);
    bf16* ws_wa_in = (bf16*)(a.ws + WS_WA_IN); bf16* ws_wa_out = (bf16*)(a.ws + WS_WA_OUT);
    bf16* ws_wb_in0 = (bf16*)(a.ws + WS_WB_IN0); bf16* ws_wb_in1 = (bf16*)(a.ws + WS_WB_IN1); bf16* ws_wb_out = (bf16*)(a.ws + WS_WB_OUT);
    constexpr int I_AIN = 16 * 64;
    constexpr int I_AOUT = 32 * 32;
    constexpr int I_BIN = 16 * 32;
    constexpr int I_KV = 16 * 8;
    constexpr int I_BOUT = 16 * 32;
    constexpr int NITEMS = 6 * I_AIN + 2 * I_AOUT + 4 * I_BIN + 2 * I_KV + 2 * I_BOUT;
    for (int it = gw; it < NITEMS; it += NGW) {
        int r = it;
        if (r < 6 * I_AIN) { const int l = r / (3 * I_AIN), part = (r / I_AIN) % 3, item = r % I_AIN;
            const int col0 = part == 0 ? 0 : (part == 1 ? 4096 : 2048);
            transpose_item(a.a_w_in + (size_t)l * 1024 * 6144, 6144, col0, 1024, ws_wa_in + (size_t)l * 6144 * 1024, part * 2048, 64, a.a_pre_g + l * 1024, 1.0f, scr, item, lane); continue; }
        r -= 6 * I_AIN;
        if (r < 2 * I_AOUT) { const int l = r / I_AOUT, item = r % I_AOUT;
            transpose_item(a.a_w_out + (size_t)l * 2048 * 1024, 1024, 0, 2048, ws_wa_out + (size_t)l * 1024 * 2048, 0, 32, nullptr, 1.0f, scr, item, lane); continue; }
        r -= 2 * I_AOUT;
        if (r < 4 * I_BIN) { const int l = r / (2 * I_BIN), part = (r / I_BIN) & 1, item = r % I_BIN;
            transpose_item(a.b_w_in + (size_t)l * 1024 * 2048, 2048, part * 1024, 1024, l ? ws_wb_in1 : ws_wb_in0, part * 1024, 32, a.b_pre_g + l * 1024, part == 0 ? 0.125f : 1.0f, scr, item, lane); continue; }
        r -= 4 * I_BIN;
        if (r < 2 * I_KV) { const int part = r / I_KV, item = r % I_KV;
            transpose_item(part ? a.w_v : a.w_k, 256, 0, 1024, ws_wb_in0, 2048 + part * 256, 8, a.kv_norm_g, 1.0f, scr, item, lane); continue; }
        r -= 2 * I_KV;
        { const int l = r / I_BOUT, item = r % I_BOUT;
            transpose_item(a.b_w_out + (size_t)l * 1024 * 1024, 1024, 0, 1024, ws_wb_out + (size_t)l * 1024 * 1024, 0, 32, nullptr, 1.0f, scr, item, lane); }
    }
    bf16* HN = (bf16*)(a.ws + WS_HN);
    for (int m = gw; m < M; m += NGW) {
        const f32x4* xr = (const f32x4*)(a.x + (size_t)m * D) + lane;
        f32x4 v[4]; float s = 0.f;
#pragma unroll
        for (int j = 0; j < 4; ++j) { v[j] = xr[64 * j]; s += (v[j].x * v[j].x + v[j].y * v[j].y) + (v[j].z * v[j].z + v[j].w * v[j].w); }
        const float r = __builtin_amdgcn_rsqf(wave_sum(s) * (1.f / D) + EPS);
        v2u* o8 = (v2u*)(HN + (size_t)m * D) + lane;
#pragma unroll
        for (int j = 0; j < 4; ++j) { v2u o; o.x = pk2(v[j].x * r, v[j].y * r); o.y = pk2(v[j].z * r, v[j].w * r); o8[64 * j] = o; }
    }
}

__device__ __forceinline__ void row_phase(const float* Y, const float* Hsrc, float* Hdst, const float* post_g, bf16* HN, bool need_hn, int gw, int NGW, int lane) {
    f32x4 g[4];
#pragma unroll
    for (int j = 0; j < 4; ++j) g[j] = ((const f32x4*)post_g)[lane + 64 * j];
    for (int m = gw; m < M; m += NGW) {
        const f32x4* yr = (const f32x4*)(Y + (size_t)m * D) + lane; const f32x4* hr = (const f32x4*)(Hsrc + (size_t)m * D) + lane;
        f32x4 y[4], h[4]; float s = 0.f;
#pragma unroll
        for (int j = 0; j < 4; ++j) { y[j] = yr[64 * j]; h[j] = hr[64 * j]; s += (y[j].x * y[j].x + y[j].y * y[j].y) + (y[j].z * y[j].z + y[j].w * y[j].w); }
        const float r1 = __builtin_amdgcn_rsqf(wave_sum(s) * (1.f / D) + EPS);
        float s2 = 0.f; f32x4* ho = (f32x4*)(Hdst + (size_t)m * D) + lane;
#pragma unroll
        for (int j = 0; j < 4; ++j) { h[j] = h[j] + y[j] * r1 * g[j]; ho[64 * j] = h[j]; s2 += (h[j].x * h[j].x + h[j].y * h[j].y) + (h[j].z * h[j].z + h[j].w * h[j].w); }
        if (need_hn) {
            const float r2 = __builtin_amdgcn_rsqf(wave_sum(s2) * (1.f / D) + EPS);
            v2u* o8 = (v2u*)(HN + (size_t)m * D) + lane;
#pragma unroll
            for (int j = 0; j < 4; ++j) { v2u o; o.x = pk2(h[j].x * r2, h[j].y * r2); o.y = pk2(h[j].z * r2, h[j].w * r2); o8[64 * j] = o; }
        }
    }
}

constexpr int WL_STRIDE = 136;
__device__ __forceinline__ void gate_phase(const Args& a, int layer, LAS unsigned char* lds, int G, int tid, int wave, int lane) {
    LAS bf16* Wl = (LAS bf16*)lds;
    LAS float* mu_l = (LAS float*)(lds + 128 * WL_STRIDE * 2);
    LAS float* rs_l = mu_l + 128;
    bf16* U = (bf16*)(a.ws + WS_U); const bf16* Z = (const bf16*)(a.ws + WS_Z); const bf16* VT = (const bf16*)(a.ws + WS_VT);
    const float* ssum = (const float*)(a.ws + WS_STAT); const float* ssq = ssum + (size_t)16 * M;
    const int fr = lane & 15, fq = lane >> 4;
    int cur_g = -1;
    for (int it = blockIdx.x; it < 4096; it += G) {
        const int g = it & 7, chunk = it >> 3; const size_t tok0 = (size_t)chunk * CH;
        __syncthreads();
        if (g != cur_g) { cur_g = g;
            const int t = tid >> 2, s0 = (tid & 3) * 32; const float* wsrc = a.a_w_s + (((size_t)layer * 8 + g) * CH + t) * CH + s0;
#pragma unroll
            for (int j = 0; j < 4; ++j) { const f32x4 w0 = *(const f32x4*)(wsrc + 8 * j), w1 = *(const f32x4*)(wsrc + 8 * j + 4); const int s = s0 + 8 * j;
                v4u o; o.x = pk2(s + 0 <= t ? w0.x : 0.f, s + 1 <= t ? w0.y : 0.f); o.y = pk2(s + 2 <= t ? w0.z : 0.f, s + 3 <= t ? w0.w : 0.f);
                o.z = pk2(s + 4 <= t ? w1.x : 0.f, s + 5 <= t ? w1.y : 0.f); o.w = pk2(s + 6 <= t ? w1.z : 0.f, s + 7 <= t ? w1.w : 0.f);
                *(LAS v4u*)(Wl + t * WL_STRIDE + s) = o; } }
        if (tid < CH) { float s = 0.f, q = 0.f;
#pragma unroll
            for (int k = 0; k < 16; ++k) { s += ssum[(size_t)k * M + tok0 + tid]; q += ssq[(size_t)k * M + tok0 + tid]; }
            const float mu = s * (1.f / AW); const float var = fmaxf(q * (1.f / AW) - mu * mu, 0.f);
            mu_l[tid] = mu; rs_l[tid] = __builtin_amdgcn_rsqf(var + EPS); }
        __syncthreads();
        const int cb = g * 256 + wave * 32;
        bf16x8 bfr[2][4];
#pragma unroll
        for (int n = 0; n < 2; ++n) { const int ch = cb + 8 * (fr >> 2) + 4 * n + (fr & 3);
            const float lg = a.a_ln_g[layer * AW + ch], lb = a.a_ln_b[layer * AW + ch];
#pragma unroll
            for (int k = 0; k < 4; ++k) { const int s = 32 * k + 8 * fq;
                const v4u raw = *(const v4u*)(VT + (size_t)ch * M + tok0 + s);
                const f32x4 m0 = *(LAS f32x4*)(mu_l + s), m1 = *(LAS f32x4*)(mu_l + s + 4), r0 = *(LAS f32x4*)(rs_l + s), r1 = *(LAS f32x4*)(rs_l + s + 4);
                v4u o;
                o.x = pk2((bflo(raw.x) - m0.x) * r0.x * lg + lb, (bfhi(raw.x) - m0.y) * r0.y * lg + lb);
                o.y = pk2((bflo(raw.y) - m0.z) * r0.z * lg + lb, (bfhi(raw.y) - m0.w) * r0.w * lg + lb);
                o.z = pk2((bflo(raw.z) - m1.x) * r1.x * lg + lb, (bfhi(raw.z) - m1.y) * r1.y * lg + lb);
                o.w = pk2((bflo(raw.w) - m1.z) * r1.z * lg + lb, (bfhi(raw.w) - m1.w) * r1.w * lg + lb);
                bfr[n][k] = __builtin_bit_cast(bf16x8, o); } }
        const float* bsrc = a.a_b_s + ((size_t)layer * 8 + g) * CH;
#pragma unroll
        for (int mb = 0; mb < 8; ++mb) {
            f32x4 acc0 = (f32x4){0.f, 0.f, 0.f, 0.f}, acc1 = (f32x4){0.f, 0.f, 0.f, 0.f};
            const int t = 16 * mb + fr;
            const size_t off = (tok0 + t) * AW + cb + 8 * fq;
            const v4u u8 = *(const v4u*)(U + off); const v4u z8 = *(const v4u*)(Z + off);
            const float bs = bsrc[t];
#pragma unroll
            for (int k = 0; k < 4; ++k) { if (k <= (mb >> 1)) {
                const bf16x8 af = *(LAS bf16x8*)(Wl + t * WL_STRIDE + 32 * k + 8 * fq);
                acc0 = __builtin_amdgcn_mfma_f32_16x16x32_bf16(bfr[0][k], af, acc0, 0, 0, 0);
                acc1 = __builtin_amdgcn_mfma_f32_16x16x32_bf16(bfr[1][k], af, acc1, 0, 0, 0); } }
            v4u o;
            o.x = pk2(bflo(u8.x) * (acc0.x + bs) * bflo(z8.x), bfhi(u8.x) * (acc0.y + bs) * bfhi(z8.x));
            o.y = pk2(bflo(u8.y) * (acc0.z + bs) * bflo(z8.y), bfhi(u8.y) * (acc0.w + bs) * bfhi(z8.y));
            o.z = pk2(bflo(u8.z) * (acc1.x + bs) * bflo(z8.z), bfhi(u8.z) * (acc1.y + bs) * bfhi(z8.z));
            o.w = pk2(bflo(u8.w) * (acc1.z + bs) * bflo(z8.w), bfhi(u8.w) * (acc1.w + bs) * bfhi(z8.w));
            *(v4u*)(U + off) = o;
        }
    }
    __syncthreads();
}

__device__ __forceinline__ void attn_phase(const Args& a, int layer, int G, int wave, int lane) {
    bf16* Q = (bf16*)(a.ws + WS_U); const bf16* ZG = Q + (size_t)M * D;
    const bf16* KB = (const bf16*)(a.ws + WS_Z); const bf16* VTB = KB + (size_t)M * 256;
    const int fr = lane & 15, fq = lane >> 4;
    for (int it = blockIdx.x; it < 2048; it += G) {
        const int kvh = it & 3, qi = (it >> 2) & 31, b = it >> 7;
        const int h = kvh * 4 + (wave >> 1);
        const float slope = __builtin_amdgcn_exp2f(-0.5f * (float)(h + 1)) * LOG2E;
        const float sink = a.b_sinks[layer * 16 + h] * LOG2E;
        const long tokb = (long)b * SEQ + (long)qi * 128;
        for (int mb = 0; mb < 4; ++mb) {
            const int t0 = (wave & 1) * 64 + 16 * mb, nb0 = t0 >> 4;
            const bf16* qp = Q + (size_t)(tokb + t0 + fr) * D + h * 64 + 8 * fq;
            const bf16x8 qf0 = *(const bf16x8*)qp, qf1 = *(const bf16x8*)(qp + 32);
            f32x4 S[10];
#pragma unroll
            for (int nb = 0; nb < 9; ++nb) { int kb = nb0 + nb; if (qi == 0 && kb < 8) kb = 8;
                const bf16* kp = KB + (size_t)(tokb - 128 + 16 * kb + fr) * 256 + kvh * 64 + 8 * fq;
                const bf16x8 kf0 = *(const bf16x8*)kp, kf1 = *(const bf16x8*)(kp + 32);
                f32x4 z = (f32x4){0.f, 0.f, 0.f, 0.f};
                z = __builtin_amdgcn_mfma_f32_16x16x32_bf16(kf0, qf0, z, 0, 0, 0);
                S[nb] = __builtin_amdgcn_mfma_f32_16x16x32_bf16(kf1, qf1, z, 0, 0, 0); }
            const int r = t0 + fr; float mx = sink;
#pragma unroll
            for (int nb = 0; nb < 9; ++nb)
#pragma unroll
                for (int e = 0; e < 4; ++e) { const int c = 16 * (nb0 + nb) + 4 * fq + e; const int dist = 128 + r - c;
                    const bool valid = (dist >= 0) && (dist < 128) && (qi > 0 || c >= 128);
                    const float lg = S[nb][e] * LOG2E - slope * (float)dist;
                    S[nb][e] = valid ? lg : -INFINITY; mx = fmaxf(mx, S[nb][e]); }
            mx = fmaxf(mx, __shfl_xor(mx, 16)); mx = fmaxf(mx, __shfl_xor(mx, 32));
            float den = 0.f;
#pragma unroll
            for (int nb = 0; nb < 9; ++nb)
#pragma unroll
                for (int e = 0; e < 4; ++e) { const float p = __builtin_amdgcn_exp2f(S[nb][e] - mx); S[nb][e] = p; den += p; }
            den += __shfl_xor(den, 16); den += __shfl_xor(den, 32);
            den += __builtin_amdgcn_exp2f(sink - mx);
            S[9] = (f32x4){0.f, 0.f, 0.f, 0.f};
            f32x4 O[4];
#pragma unroll
            for (int db = 0; db < 4; ++db) O[db] = (f32x4){0.f, 0.f, 0.f, 0.f};
#pragma unroll
            for (int kk = 0; kk < 5; ++kk) {
                v4u pw; pw.x = pk2(S[2 * kk][0], S[2 * kk][1]); pw.y = pk2(S[2 * kk][2], S[2 * kk][3]); pw.z = pk2(S[2 * kk + 1][0], S[2 * kk + 1][1]); pw.w = pk2(S[2 * kk + 1][2], S[2 * kk + 1][3]);
                const bf16x8 pb = __builtin_bit_cast(bf16x8, pw);
                int kb0 = nb0 + 2 * kk, kb1 = kb0 + 1; if (kb0 > 15) kb0 = 15; if (kb1 > 15) kb1 = 15; if (qi == 0) { if (kb0 < 8) kb0 = 8; if (kb1 < 8) kb1 = 8; }
#pragma unroll
                for (int db = 0; db < 4; ++db) { const bf16* vp = VTB + (size_t)(kvh * 64 + 16 * db + fr) * M + (tokb - 128) + 4 * fq;
                    v4u vw; const v2u v0 = *(const v2u*)(vp + 16 * kb0), v1 = *(const v2u*)(vp + 16 * kb1); vw.x = v0.x; vw.y = v0.y; vw.z = v1.x; vw.w = v1.y;
                    O[db] = __builtin_amdgcn_mfma_f32_16x16x32_bf16(__builtin_bit_cast(bf16x8, vw), pb, O[db], 0, 0, 0); } }
            const float inv = __builtin_amdgcn_rcpf(den);
            const size_t orow = (size_t)(tokb + t0 + fr) * D + h * 64 + 4 * fq;
#pragma unroll
            for (int db = 0; db < 4; ++db) { const v2u zz = *(const v2u*)(ZG + orow + 16 * db);
                v2u o; o.x = pk2(O[db][0] * inv * bflo(zz.x), O[db][1] * inv * bfhi(zz.x)); o.y = pk2(O[db][2] * inv * bflo(zz.y), O[db][3] * inv * bfhi(zz.y));
                *(v2u*)(Q + orow + 16 * db) = o; }
        }
    }
}

__global__ void __launch_bounds__(NWAVES * 64, 2) yoco_fwd(Args a) {
    extern __shared__ __attribute__((aligned(16))) unsigned char lds_raw[];
    LAS unsigned char* lds = (LAS unsigned char*)lds_raw;
    cg::grid_group grid = cg::this_grid();
#define PHASE_IDS() int tid = threadIdx.x; asm volatile("" : "+v"(tid)); const int lane = tid & 63, wave = __builtin_amdgcn_readfirstlane(tid >> 6); const int gw = blockIdx.x * NWAVES + wave; (void)gw; (void)lane
    const int G = gridDim.x, NGW = G * NWAVES;
    bf16* HN = (bf16*)(a.ws + WS_HN);
    float* YOUT = (float*)(a.ws + WS_VT);

    { PHASE_IDS(); p0_prologue(a, lds, gw, NGW, wave, lane); }
    grid.sync();

    for (int l = 0; l < 2; ++l) {
        const bf16* Win = (const bf16*)(a.ws + WS_WA_IN) + (size_t)l * 6144 * 1024;
        {
            pg8::Gemm g{HN, Win, M, 4096, D}; pg8::StaticOrder S; S.init(M, 4096, G, (int)blockIdx.x);
            pg8::EpiUZ E{(bf16*)(a.ws + WS_U), (bf16*)(a.ws + WS_Z)};
            pg8::gemm_phase<pg8::EpiUZ, pg8::StaticOrder, true, true>(lds, g, S, E);
        }
        {
            pg8::Gemm g{Win + (size_t)4096 * 1024, HN, AW, M, D}; pg8::StaticOrder S; S.init(AW, M, G, (int)blockIdx.x);
            pg8::EpiT<true> E{(bf16*)(a.ws + WS_VT), (float*)(a.ws + WS_STAT), (float*)(a.ws + WS_STAT) + (size_t)16 * M};
            pg8::gemm_phase<pg8::EpiT<true>, pg8::StaticOrder, true, true>(lds, g, S, E);
        }
        grid.sync();
        { PHASE_IDS(); gate_phase(a, l, lds, G, tid, wave, lane); }
        grid.sync();
        {
            pg8::Gemm g{(const bf16*)(a.ws + WS_U), (const bf16*)(a.ws + WS_WA_OUT) + (size_t)l * 1024 * 2048, M, D, AW}; pg8::StaticOrder S; S.init(M, D, G, (int)blockIdx.x);
            pg8::EpiF32 E{YOUT, D};
            pg8::gemm_phase<pg8::EpiF32, pg8::StaticOrder, true, true>(lds, g, S, E);
        }
        grid.sync();
        { PHASE_IDS(); row_phase(YOUT, l == 0 ? a.x : a.out, a.out, a.a_post_g + l * D, HN, true, gw, NGW, lane); }
        grid.sync();
    }
    for (int l = 0; l < 2; ++l) {
        const bf16* Win = (const bf16*)(a.ws + (l ? WS_WB_IN1 : WS_WB_IN0));
        bf16* Q = (bf16*)(a.ws + WS_U); bf16* ZG = Q + (size_t)M * D; bf16* KB = (bf16*)(a.ws + WS_Z); bf16* VTB = KB + (size_t)M * 256;
        {
            const int N = l ? 2048 : 2304;
            pg8::Gemm g{HN, Win, M, N, D}; pg8::StaticOrder S; S.init(M, N, G, (int)blockIdx.x);
            pg8::EpiBin E{a.ws};
            pg8::gemm_phase<pg8::EpiBin, pg8::StaticOrder, true, true>(lds, g, S, E);
        }
        if (l == 0) {
            pg8::Gemm g{Win + (size_t)2304 * 1024, HN, 256, M, D}; pg8::StaticOrder S; S.init(256, M, G, (int)blockIdx.x);
            pg8::EpiT<false> E{VTB, nullptr, nullptr};
            pg8::gemm_phase<pg8::EpiT<false>, pg8::StaticOrder, true, true>(lds, g, S, E);
        }
        grid.sync();
        { PHASE_IDS(); attn_phase(a, l, G, wave, lane); }
        grid.sync();
        {
            pg8::Gemm g{Q, (const bf16*)(a.ws + WS_WB_OUT) + (size_t)l * 1024 * 1024, M, D, D}; pg8::StaticOrder S; S.init(M, D, G, (int)blockIdx.x);
            pg8::EpiF32 E{YOUT, D};
            pg8::gemm_phase<pg8::EpiF32, pg8::StaticOrder, true, true>(lds, g, S, E);
        }
        grid.sync();
        { PHASE_IDS(); row_phase(YOUT, a.out, a.out, a.b_post_g + l * D, HN, l == 0, gw, NGW, lane); }
        if (l == 0) grid.sync();
    }
}

extern "C" void kernel_launch(void* const* d_in, const int* in_sizes, int n_in, void* d_out, int out_size, void* d_ws, size_t ws_size, hipStream_t stream) {
    static int grid = 0;
    if (grid == 0) {
        if (n_in != 17 || in_sizes[0] != M * D || out_size != M * D || ws_size < WS_END) { fprintf(stderr, "kernel_launch: unexpected shapes (n_in %d, in0 %d, out %d, ws %zu)\n", n_in, n_in > 0 ? in_sizes[0] : -1, out_size, ws_size); grid = -1; return; }
        int dev = 0, cus = 0, per_cu = 0;
        hipGetDevice(&dev); hipDeviceGetAttribute(&cus, hipDeviceAttributeMultiprocessorCount, dev);
        if (hipFuncSetAttribute((const void*)yoco_fwd, hipFuncAttributeMaxDynamicSharedMemorySize, LDS_BYTES) != hipSuccess) { fprintf(stderr, "kernel_launch: hipFuncSetAttribute failed\n"); grid = -1; return; }
        if (hipOccupancyMaxActiveBlocksPerMultiprocessor(&per_cu, (const void*)yoco_fwd, NWAVES * 64, LDS_BYTES) != hipSuccess || per_cu < 1) { fprintf(stderr, "kernel_launch: occupancy query says %d\n", per_cu); per_cu = 1; }
        (void)hipGetLastError();
        grid = cus;
    }
    if (grid < 0) return;
    Args a{};
    a.x = (const float*)d_in[0]; a.a_w_in = (const float*)d_in[1]; a.a_ln_g = (const float*)d_in[2]; a.a_ln_b = (const float*)d_in[3]; a.a_w_s = (const float*)d_in[4];
    a.a_b_s = (const float*)d_in[5]; a.a_w_out = (const float*)d_in[6]; a.a_pre_g = (const float*)d_in[7]; a.a_post_g = (const float*)d_in[8]; a.kv_norm_g = (const float*)d_in[9];
    a.w_k = (const float*)d_in[10]; a.w_v = (const float*)d_in[11]; a.b_w_in = (const float*)d_in[12]; a.b_sinks = (const float*)d_in[13]; a.b_w_out = (const float*)d_in[14];
    a.b_pre_g = (const float*)d_in[15]; a.b_post_g = (const float*)d_in[16];
    a.out = (float*)d_out; a.ws = (unsigned char*)d_ws;
    void* args[] = {&a};
    hipError_t e = hipLaunchCooperativeKernel((const void*)yoco_fwd, dim3(grid), dim3(NWAVES * 64), args, LDS_BYTES, stream);
    if (e != hipSuccess) fprintf(stderr, "kernel_launch: cooperative launch failed: %s (grid %d)\n", hipGetErrorString(e), grid);
}
```

```cpp
#include <hip/hip_runtime.h>
#include <hip/hip_cooperative_groups.h>
#include <cstdio>
#include <cstdint>
namespace cg = cooperative_groups;
namespace pg8 {
#define PG8_LAS __attribute__((address_space(3)))
typedef unsigned short bf16_t;
typedef short bf16x8 __attribute__((ext_vector_type(8)));
typedef float f32x4 __attribute__((ext_vector_type(4)));
typedef unsigned u32x4 __attribute__((ext_vector_type(4)));
constexpr int BM = 256, BK = 64, HALF = 128, HTB = HALF * BK * 2  , STAGE_BYTES = 8 * HTB, NXCD = 8, WGM = 8;

__host__ __device__ __forceinline__ int lds_byte(int r, int c) { const int st = (r >> 4) * 2 + (c >> 5), rr = r & 15, cc = c & 31, ob = rr * 64 + cc * 2; return st * 1024 + (ob ^ (((ob >> 9) & 1) << 5)); }
__host__ __device__ __forceinline__ void stage_rc(int b, int& R, int& C) { const int st = b / 1024, sb = b % 1024, swz = sb ^ (((sb >> 9) & 1) << 5); R = (st >> 1) * 16 + swz / 64; C = (st & 1) * 32 + (swz % 64) / 2; }
__host__ __device__ __forceinline__ int perm32(int rho) { const int n = rho >> 4, i = rho & 15; return 8 * (i >> 2) + 4 * n + (i & 3); }

struct Unit { int pm, pn; };
struct Gemm { const bf16_t* A; const bf16_t* Bt; int M, N, K; };

struct StaticOrder {
    int nM, nN, nwg, G, c;
    __host__ __device__ void init(int M, int N, int G_, int c_) { nM = M / BM; nN = N / BM; nwg = nM * nN; G = G_; c = c_; }
    __host__ __device__ bool next(int i, Unit& u) const {
        const long L = (long)i * G + c; if (L >= nwg) return false;
        int wgid = (int)L; { const int q = nwg / NXCD, r = nwg % NXCD, xcd = wgid % NXCD, off = wgid / NXCD; wgid = (xcd < r ? xcd * (q + 1) : r * (q + 1) + (xcd - r) * q) + off; }
        const int nig = WGM * nN, gid = wgid / nig, fm = gid * WGM, gsz = (nM - fm) < WGM ? (nM - fm) : WGM;
        u.pm = fm + ((wgid % nig) % gsz); u.pn = (wgid % nig) / gsz; return true;
    }
    __device__ __forceinline__ void a_ready(const Unit&) const {}
    __device__ __forceinline__ void done(const Unit&) const {}
};
__device__ __forceinline__ unsigned cvt_pk_bf16(float lo, float hi) { unsigned r; asm volatile("v_cvt_pk_bf16_f32 %0, %1, %2" : "=v"(r) : "v"(lo), "v"(hi)); return r; }
typedef float f32x2 __attribute__((ext_vector_type(2)));
template <class Epi, class Sched, bool ALIGN_EPI = false, bool SP2 = false>
__device__ __forceinline__ void gemm_phase(PG8_LAS unsigned char* lds, const Gemm g, const Sched& S, const Epi& E) {
    int tid_l = threadIdx.x; asm volatile("" : "+v"(tid_l));
    const int tid = tid_l, wid = __builtin_amdgcn_readfirstlane(tid >> 6), lane = tid & 63, wr = wid >> 2, wc = wid & 3, fr = lane & 15, fq = lane >> 4;
    const int K = g.K, nt = K / BK;
    unsigned voffA[2], voffB[2];
#pragma unroll
    for (int i = 0; i < 2; ++i) { int R, C; stage_rc(tid * 16 + i * 8192, R, C); const int Rb = Epi::PERM ? ((R & ~31) + perm32(R & 31)) : R;
        voffA[i] = (unsigned)(R * K + C) * 2u; voffB[i] = (unsigned)(Rb * K + C) * 2u; }
    const size_t kstep = (size_t)(BK * 2);
    const size_t hstep = (size_t)HALF * K * 2;
    const size_t tstep = 2 * hstep;
    const unsigned ldsw = (unsigned)wid * 1024u;
    const int aoff = lds_byte(wr * 64 + fr, fq * 8), boff = lds_byte(wc * 32 + fr, fq * 8);
#define PG8_SA(b, h) (((b) * 2 + (h)) * HTB)
#define PG8_SB(b, h) ((4 + (b) * 2 + (h)) * HTB)
#define PG8_STAGE(bufoff, gbase, voff) do { _Pragma("unroll") for (int _i = 0; _i < 2; ++_i) \
        __builtin_amdgcn_global_load_lds((const unsigned*)((const char*)(gbase) + (voff)[_i]), (PG8_LAS unsigned*)(lds + (bufoff) + ldsw + _i * 8192), 16, 0, 0); } while (0)
#define PG8_LDA(dst, b, h) do { _Pragma("unroll") for (int m = 0; m < 4; ++m) _Pragma("unroll") for (int k = 0; k < 2; ++k) dst[m][k] = *(const PG8_LAS bf16x8*)(lds + PG8_SA(b, h) + aoff + m * 2048 + k * 1024); } while (0)
#define PG8_LDB(dst, b, h) do { _Pragma("unroll") for (int n = 0; n < 2; ++n) _Pragma("unroll") for (int k = 0; k < 2; ++k) dst[n][k] = *(const PG8_LAS bf16x8*)(lds + PG8_SB(b, h) + boff + n * 2048 + k * 1024); } while (0)
#define PG8_MMA(ai, bj, At, Bt) do { __builtin_amdgcn_s_setprio(1); _Pragma("unroll") for (int m = 0; m < 4; ++m) _Pragma("unroll") for (int n = 0; n < 2; ++n) _Pragma("unroll") for (int k = 0; k < 2; ++k) \
        acc[ai][bj][m][n] = __builtin_amdgcn_mfma_f32_16x16x32_bf16(Bt[n][k], At[m][k], acc[ai][bj][m][n], 0, 0, 0); __builtin_amdgcn_s_setprio(0); } while (0)
#define PG8_WAIT_V(n) asm volatile("s_waitcnt vmcnt(" #n ")" ::: "memory")
#define PG8_WAIT_L(n) asm volatile("s_waitcnt lgkmcnt(" #n ")" ::: "memory")
#define PG8_BAR __builtin_amdgcn_s_barrier()
#define PG8_SCHED __builtin_amdgcn_sched_barrier(0)
    Unit cur, nxt; int ui = 0;
    if (!S.next(0, cur)) return;
    f32x4 acc[2][2][4][2];
#pragma unroll
    for (int a = 0; a < 2; ++a)
#pragma unroll
        for (int b = 0; b < 2; ++b)
#pragma unroll
            for (int m = 0; m < 4; ++m)
#pragma unroll
                for (int n = 0; n < 2; ++n) acc[a][b][m][n] = (f32x4){0.f, 0.f, 0.f, 0.f};
    bf16x8 At[4][2], B0[2][2], B1[2][2];
    const char* cA = (const char*)g.A + (size_t)cur.pm * tstep; const char* cB = (const char*)g.Bt + (size_t)cur.pn * tstep;
    S.a_ready(cur);
    if constexpr (SP2) {
        PG8_STAGE(PG8_SB(0, 0), cB, voffB); PG8_STAGE(PG8_SB(0, 1), cB + hstep, voffB); PG8_STAGE(PG8_SA(0, 0), cA, voffA); PG8_STAGE(PG8_SA(0, 1), cA + hstep, voffA);
        if (wr == 1) PG8_BAR;
        PG8_WAIT_V(2); PG8_BAR;
        PG8_STAGE(PG8_SB(1, 0), cB + kstep, voffB); PG8_STAGE(PG8_SA(1, 0), cA + kstep, voffA); PG8_STAGE(PG8_SB(1, 1), cB + hstep + kstep, voffB);
        PG8_WAIT_V(6); PG8_BAR;
    } else {
        PG8_STAGE(PG8_SB(0, 0), cB, voffB); PG8_STAGE(PG8_SA(0, 0), cA, voffA); PG8_STAGE(PG8_SB(0, 1), cB + hstep, voffB); PG8_STAGE(PG8_SA(0, 1), cA + hstep, voffA);
        if (wr == 1) PG8_BAR;
        PG8_WAIT_V(4); PG8_BAR;
        PG8_STAGE(PG8_SB(1, 0), cB + kstep, voffB); PG8_STAGE(PG8_SA(1, 0), cA + kstep, voffA); PG8_STAGE(PG8_SB(1, 1), cB + hstep + kstep, voffB);
        PG8_WAIT_V(6); PG8_BAR;
    }
    for (;;) {
        const bool has_next = S.next(ui + 1, nxt);
        const char* nA = has_next ? (const char*)g.A + (size_t)nxt.pm * tstep : cA; const char* nB = has_next ? (const char*)g.Bt + (size_t)nxt.pn * tstep : cB;
        for (int t = 0; t < nt; t += 2) {
            const bool last = (t == nt - 2);
            const char* a1 = cA + (size_t)(t + 1) * kstep;
            const char* a2 = last ? nA : cA + (size_t)(t + 2) * kstep; const char* b2 = last ? nB : cB + (size_t)(t + 2) * kstep;
            const char* a3 = a2 + kstep; const char* b3 = b2 + kstep;
            if (last && has_next) S.a_ready(nxt);
            if constexpr (SP2) {
            PG8_LDB(B0, 0, 0); PG8_LDB(B1, 0, 1); PG8_SCHED; PG8_LDA(At, 0, 0); PG8_STAGE(PG8_SA(1, 1), a1 + hstep, voffA);
            PG8_WAIT_V(8); PG8_WAIT_L(0); PG8_BAR; PG8_MMA(0, 0, At, B0); PG8_MMA(0, 1, At, B1); PG8_BAR; PG8_SCHED;
            PG8_LDA(At, 0, 1); PG8_STAGE(PG8_SB(0, 0), b2, voffB); PG8_STAGE(PG8_SB(0, 1), b2 + hstep, voffB); PG8_STAGE(PG8_SA(0, 0), a2, voffA);
            PG8_WAIT_V(8); PG8_WAIT_L(0); PG8_BAR; PG8_MMA(1, 0, At, B0); PG8_MMA(1, 1, At, B1); PG8_BAR; PG8_SCHED;
            PG8_LDB(B0, 1, 0); PG8_LDB(B1, 1, 1); PG8_SCHED; PG8_LDA(At, 1, 0); PG8_STAGE(PG8_SA(0, 1), a2 + hstep, voffA);
            PG8_WAIT_V(8); PG8_WAIT_L(0); PG8_BAR; PG8_MMA(0, 0, At, B0); PG8_MMA(0, 1, At, B1); PG8_BAR; PG8_SCHED;
            PG8_LDA(At, 1, 1); PG8_STAGE(PG8_SB(1, 0), b3, voffB); PG8_STAGE(PG8_SB(1, 1), b3 + hstep, voffB); PG8_STAGE(PG8_SA(1, 0), a3, voffA);
            PG8_WAIT_V(8); PG8_WAIT_L(0); PG8_BAR; PG8_MMA(1, 0, At, B0); PG8_MMA(1, 1, At, B1); PG8_BAR; PG8_SCHED;
            } else {
            PG8_LDB(B0, 0, 0); PG8_SCHED; PG8_LDA(At, 0, 0); PG8_STAGE(PG8_SA(1, 1), a1 + hstep, voffA);
            PG8_WAIT_L(8); PG8_BAR; PG8_WAIT_L(0); PG8_MMA(0, 0, At, B0); PG8_BAR; PG8_SCHED;
            PG8_LDB(B1, 0, 1); PG8_STAGE(PG8_SB(0, 0), b2, voffB);
            PG8_BAR; PG8_WAIT_L(0); PG8_MMA(0, 1, At, B1); PG8_BAR;
            PG8_LDA(At, 0, 1); PG8_STAGE(PG8_SA(0, 0), a2, voffA);
            PG8_BAR; PG8_WAIT_L(0); PG8_MMA(1, 0, At, B0); PG8_BAR; PG8_SCHED;
            PG8_STAGE(PG8_SB(0, 1), b2 + hstep, voffB);
            PG8_WAIT_V(6); PG8_BAR; PG8_MMA(1, 1, At, B1); PG8_BAR;
            PG8_LDB(B0, 1, 0); PG8_SCHED; PG8_LDA(At, 1, 0); PG8_STAGE(PG8_SA(0, 1), a2 + hstep, voffA);
            PG8_WAIT_L(8); PG8_BAR; PG8_WAIT_L(0); PG8_MMA(0, 0, At, B0); PG8_BAR; PG8_SCHED;
            PG8_LDB(B1, 1, 1); PG8_STAGE(PG8_SB(1, 0), b3, voffB);
            PG8_BAR; PG8_WAIT_L(0); PG8_MMA(0, 1, At, B1); PG8_BAR;
            PG8_LDA(At, 1, 1); PG8_STAGE(PG8_SA(1, 0), a3, voffA);
            PG8_BAR; PG8_WAIT_L(0); PG8_MMA(1, 0, At, B0); PG8_BAR; PG8_SCHED;
            PG8_STAGE(PG8_SB(1, 1), b3 + hstep, voffB);
            PG8_WAIT_V(6); PG8_BAR; PG8_MMA(1, 1, At, B1); PG8_BAR;
            }
        }
        if constexpr (ALIGN_EPI) { if (wr == 0) PG8_BAR; }
        if constexpr (!Epi::AFTER_DRAIN) { E(acc, cur, wr, wc, fr, fq); S.done(cur); }
        if (!has_next) break;
#pragma unroll
        for (int a = 0; a < 2; ++a)
#pragma unroll
            for (int b = 0; b < 2; ++b)
#pragma unroll
                for (int m = 0; m < 4; ++m)
#pragma unroll
                    for (int n = 0; n < 2; ++n) acc[a][b][m][n] = (f32x4){0.f, 0.f, 0.f, 0.f};
        cur = nxt; cA = nA; cB = nB; ++ui;
        if constexpr (ALIGN_EPI) { if (wr == 1) PG8_BAR; }
    }
    PG8_WAIT_V(0);
    if constexpr (!ALIGN_EPI) { if (wr == 0) PG8_BAR; }
    PG8_BAR;
    if constexpr (Epi::AFTER_DRAIN) { E.fused(acc, cur, wr, wc, fr, fq, lds, wid, lane); S.done(cur); }
#undef PG8_SA
#undef PG8_SB
#undef PG8_STAGE
#undef PG8_LDA
#undef PG8_LDB
#undef PG8_MMA
#undef PG8_WAIT_V
#undef PG8_WAIT_L
#undef PG8_BAR
#undef PG8_SCHED
}
}


constexpr int NWAVES = 8;
constexpr int M = 65536, D = 1024, AW = 2048, SEQ = 4096, CH = 128;
constexpr float EPS = 1e-6f;
constexpr size_t MiB = 1u << 20;
constexpr size_t WS_WA_IN = 1 * MiB;
constexpr size_t WS_WA_OUT = 25 * MiB;
constexpr size_t WS_WB_IN0 = 33 * MiB;
constexpr size_t WS_WB_IN1 = 38 * MiB;
constexpr size_t WS_WB_OUT = 42 * MiB;
constexpr size_t WS_STAT = 46 * MiB;
constexpr size_t WS_RINV = 54 * MiB;
constexpr size_t WS_W16 = 55 * MiB;
constexpr size_t WS_MU = 56 * MiB;
constexpr size_t WS_RSTD = 57 * MiB;
constexpr size_t WS_HN = 64 * MiB;
constexpr size_t WS_U = 192 * MiB;
constexpr size_t WS_VT = 448 * MiB;
constexpr size_t WS_Z = 704 * MiB;
constexpr size_t WS_END = 960 * MiB;
constexpr int LDS_WL = 131072, LDS_WL_BYTES = 20 * 1280;
constexpr int LDS_MISC = LDS_WL + LDS_WL_BYTES;
constexpr int LDS_ST = LDS_MISC + 512;
constexpr int LDS_BYTES = LDS_ST + 4096;

#define LAS __attribute__((address_space(3)))
typedef unsigned short bf16;
typedef unsigned v4u __attribute__((ext_vector_type(4)));
typedef unsigned v2u __attribute__((ext_vector_type(2)));
typedef float f32x4 __attribute__((ext_vector_type(4)));
typedef short bf16x8 __attribute__((ext_vector_type(8)));
typedef short bf16x4 __attribute__((ext_vector_type(4)));

__device__ __forceinline__ unsigned f2bf(float f) { unsigned u = __builtin_bit_cast(unsigned, f); return (u + 0x7fffu + ((u >> 16) & 1u)) >> 16; }
__device__ __forceinline__ unsigned pk2(float lo, float hi) { return pg8::cvt_pk_bf16(lo, hi); }
__device__ __forceinline__ float bflo(unsigned w) { return __builtin_bit_cast(float, w << 16); }
__device__ __forceinline__ float bfhi(unsigned w) { return __builtin_bit_cast(float, w & 0xffff0000u); }
__device__ __forceinline__ float wave_sum(float v) {
#pragma unroll
    for (int o = 1; o < 64; o <<= 1) v += __shfl_xor(v, o);
    return v;
}
__device__ __forceinline__ float act_sig(float x, float c1n, float c3n) {
    const float t = x * (c1n + c3n * x * x);
    return x * __builtin_amdgcn_rcpf(1.0f + __builtin_amdgcn_exp2f(t));
}
__device__ __forceinline__ float row16_sum(float v) {
    v += __builtin_bit_cast(float, __builtin_amdgcn_update_dpp(0, __builtin_bit_cast(int, v), 0xB1, 0xF, 0xF, false));
    v += __builtin_bit_cast(float, __builtin_amdgcn_update_dpp(0, __builtin_bit_cast(int, v), 0x4E, 0xF, 0xF, false));
    v += __builtin_bit_cast(float, __builtin_amdgcn_update_dpp(0, __builtin_bit_cast(int, v), 0x141, 0xF, 0xF, false));
    v += __builtin_bit_cast(float, __builtin_amdgcn_update_dpp(0, __builtin_bit_cast(int, v), 0x140, 0xF, 0xF, false));
    return v;
}
__device__ __forceinline__ float silu_f(float x) { return x * __builtin_amdgcn_rcpf(1.0f + __builtin_amdgcn_exp2f(x * -1.4426950408889634f)); }
constexpr float LOG2E = 1.4426950408889634f;
constexpr float GELU_C1N = -1.5957691216057308f * LOG2E, GELU_C3N = -0.07135481627f * LOG2E, SILU_C1N = -LOG2E;

namespace pg8 {
struct EpiUZ {
    static constexpr bool PERM = true, AFTER_DRAIN = false;
    bf16_t* U; bf16_t* Z; const float* rinv;
    __device__ __forceinline__ void operator()(const f32x4 (&acc)[2][2][4][2], const Unit& u, int wr, int wc, int fr, int fq) const {
        const bool isz = u.pn >= 8; bf16_t* base = isz ? Z : U;
        const float c1 = isz ? SILU_C1N : GELU_C1N, c3 = isz ? 0.f : GELU_C3N;
        const int row0 = u.pm * BM + wr * 64 + fr, col0 = (u.pn & 7) * BM + wc * 32 + 8 * fq;
#pragma unroll
        for (int ai = 0; ai < 2; ++ai)
#pragma unroll
            for (int m = 0; m < 4; ++m) { bf16_t* rowp = base + (size_t)(row0 + ai * HALF + m * 16) * AW + col0; const float rs = rinv[row0 + ai * HALF + m * 16];
#pragma unroll
                for (int bj = 0; bj < 2; ++bj) { const f32x4 v0 = acc[ai][bj][m][0] * rs, v1 = acc[ai][bj][m][1] * rs; u32x4 w;
                    w.x = cvt_pk_bf16(act_sig(v0[0], c1, c3), act_sig(v0[1], c1, c3)); w.y = cvt_pk_bf16(act_sig(v0[2], c1, c3), act_sig(v0[3], c1, c3));
                    w.z = cvt_pk_bf16(act_sig(v1[0], c1, c3), act_sig(v1[1], c1, c3)); w.w = cvt_pk_bf16(act_sig(v1[2], c1, c3), act_sig(v1[3], c1, c3));
                    __builtin_nontemporal_store(w, (u32x4*)(rowp + bj * HALF)); } }
    }
};
template <bool GELU> struct EpiT {
    static constexpr bool PERM = true, AFTER_DRAIN = false;
    bf16_t* OT; float* ssum; float* ssq; int nch; const float* rinv;
    __device__ __forceinline__ void operator()(const f32x4 (&acc)[2][2][4][2], const Unit& u, int wr, int wc, int fr, int fq) const {
        const int row0 = u.pm * BM + wr * 64 + fr, col0 = u.pn * BM + wc * 32 + 8 * fq;
        f32x4 s[2][2], q[2][2], rs[2][2];
#pragma unroll
        for (int bj = 0; bj < 2; ++bj)
#pragma unroll
            for (int n = 0; n < 2; ++n) { s[bj][n] = (f32x4){0.f, 0.f, 0.f, 0.f}; q[bj][n] = (f32x4){0.f, 0.f, 0.f, 0.f}; rs[bj][n] = *(const f32x4*)(rinv + col0 + bj * HALF + 4 * n); }
#pragma unroll
        for (int ai = 0; ai < 2; ++ai)
#pragma unroll
            for (int m = 0; m < 4; ++m) { bf16_t* rowp = OT + ((size_t)(u.pn * 2) * nch + (row0 + ai * HALF + m * 16)) * 128 + wc * 32 + 8 * fq;
#pragma unroll
                for (int bj = 0; bj < 2; ++bj) { f32x4 v0 = acc[ai][bj][m][0] * rs[bj][0], v1 = acc[ai][bj][m][1] * rs[bj][1];
                    if (GELU) {
#pragma unroll
                        for (int j = 0; j < 4; ++j) { v0[j] = act_sig(v0[j], GELU_C1N, GELU_C3N); v1[j] = act_sig(v1[j], GELU_C1N, GELU_C3N); }
                        s[bj][0] += v0; s[bj][1] += v1; q[bj][0] += v0 * v0; q[bj][1] += v1 * v1; }
                    u32x4 w; w.x = cvt_pk_bf16(v0[0], v0[1]); w.y = cvt_pk_bf16(v0[2], v0[3]); w.z = cvt_pk_bf16(v1[0], v1[1]); w.w = cvt_pk_bf16(v1[2], v1[3]);
                    __builtin_nontemporal_store(w, (u32x4*)(rowp + (size_t)bj * nch * 128)); } }
        if (GELU) {
#pragma unroll
            for (int bj = 0; bj < 2; ++bj)
#pragma unroll
                for (int n = 0; n < 2; ++n)
#pragma unroll
                    for (int j = 0; j < 4; ++j) { s[bj][n][j] = row16_sum(s[bj][n][j]); q[bj][n][j] = row16_sum(q[bj][n][j]); }
            if (fr == 0) { const size_t slot = (size_t)(u.pm * 2 + wr) * M + col0;
#pragma unroll
                for (int bj = 0; bj < 2; ++bj)
#pragma unroll
                    for (int n = 0; n < 2; ++n) { *(f32x4*)(ssum + slot + bj * HALF + 4 * n) = s[bj][n]; *(f32x4*)(ssq + slot + bj * HALF + 4 * n) = q[bj][n]; } }
        }
    }
};
struct EpiBin {
    static constexpr bool PERM = true, AFTER_DRAIN = false;
    unsigned char* ws; const float* rinv;
    __device__ __forceinline__ void operator()(const f32x4 (&acc)[2][2][4][2], const Unit& u, int wr, int wc, int fr, int fq) const {
        const bool isz = (u.pn >= 4) && (u.pn < 8); const bool isk = u.pn >= 8;
        const size_t boff = isk ? (size_t)(WS_Z) : (isz ? (size_t)(WS_U + (size_t)M * D * 2) : (size_t)WS_U);
        bf16_t* base = (bf16_t*)(ws + boff); const int ldc = isk ? 256 : 1024;
        const int row0 = u.pm * BM + wr * 64 + fr, col0 = (isk ? 0 : (u.pn & 3) * BM) + wc * 32 + 8 * fq;
#pragma unroll
        for (int ai = 0; ai < 2; ++ai)
#pragma unroll
            for (int m = 0; m < 4; ++m) { bf16_t* rowp = base + (size_t)(row0 + ai * HALF + m * 16) * ldc + col0; const float rs = rinv[row0 + ai * HALF + m * 16];
#pragma unroll
                for (int bj = 0; bj < 2; ++bj) { f32x4 v0 = acc[ai][bj][m][0] * rs, v1 = acc[ai][bj][m][1] * rs;
                    if (isz) { v0 = (f32x4){silu_f(v0.x), silu_f(v0.y), silu_f(v0.z), silu_f(v0.w)};
                        v1 = (f32x4){silu_f(v1.x), silu_f(v1.y), silu_f(v1.z), silu_f(v1.w)}; }
                    u32x4 w; w.x = cvt_pk_bf16(v0[0], v0[1]); w.y = cvt_pk_bf16(v0[2], v0[3]); w.z = cvt_pk_bf16(v1[0], v1[1]); w.w = cvt_pk_bf16(v1[2], v1[3]);
                    __builtin_nontemporal_store(w, (u32x4*)(rowp + bj * HALF)); } }
    }
};
struct GroupOrder {
    int c, G;
    __device__ __forceinline__ bool next(int i, Unit& u) const { const int J8 = G >> 6, j = c >> 3, off = (j >> 3) + J8 * i; if (off >= 32) return false; u.pn = j & 7; u.pm = 32 * (c & 7) + off; return true; }
    __device__ __forceinline__ void a_ready(const Unit&) const {}
    __device__ __forceinline__ void done(const Unit&) const {}
};
struct EpiZGate {
    static constexpr bool PERM = true, AFTER_DRAIN = false;
    bf16_t* U; const bf16_t* VT; const float* rinv; const float* mu; const float* rstd;
    const float* lng; const float* lnb; const float* bsv; PG8_LAS unsigned char* wl; PG8_LAS unsigned char* st; int off0, J8;
    __device__ __forceinline__ void load_raw(u32x4 (&raw)[2][4], int chunk, int cb, int wr, int fr, int fq) const {
#pragma unroll
        for (int n = 0; n < 2; ++n) { const int ch = cb + 8 * (fr >> 2) + 4 * n + (fr & 3); const bf16_t* vp = VT + ((size_t)chunk * 2048 + ch) * 128 + 8 * fq;
#pragma unroll
            for (int k = 0; k < 4; ++k) { if (k <= 2 * wr + 1) raw[n][k] = *(const u32x4*)(vp + 32 * k); } }
    }
    __device__ __forceinline__ void operator()(const f32x4 (&acc)[2][2][4][2], const Unit& u, int wr, int wc, int fr_in, int fq_in) const {
        const int g = u.pn;
        const int uidx = ((u.pm & 31) - off0) / J8; const PG8_LAS unsigned char* stc = st + (uidx & 1) * 2048; PG8_LAS unsigned char* stn = st + ((uidx + 1) & 1) * 2048;
        asm volatile("s_waitcnt lgkmcnt(0)" ::: "memory"); __builtin_amdgcn_s_barrier(); asm volatile("" ::: "memory");
        float stnext;
        { const int tid = (wr * 4 + wc) * 64 + fq_in * 16 + fr_in; int pmn = u.pm + J8; if ((pmn & 31) < (u.pm & 31)) pmn = u.pm;
          stnext = (tid < 256 ? mu : rstd)[(size_t)pmn * 256 + (tid & 255)]; }
        u32x4 raw[2][4], zs[3][4], un[4]; float rs0[4], bs[4], lgn[2], lbn[2];
        {
            int fr = fr_in, fq = fq_in; asm volatile("" : "+v"(fr), "+v"(fq));
            float rs1[4];
#pragma unroll
            for (int m = 0; m < 4; ++m) { const int t = 64 * wr + 16 * m + fr; rs1[m] = rinv[(size_t)(2 * u.pm + 1) * 128 + t]; rs0[m] = rinv[(size_t)(2 * u.pm) * 128 + t]; bs[m] = bsv[g * 128 + t]; }
#pragma unroll
            for (int n = 0; n < 2; ++n) { const int ch = g * 256 + 32 * wc + 8 * (fr >> 2) + 4 * n + (fr & 3); lgn[n] = lng[ch]; lbn[n] = lnb[ch]; }
            asm volatile("" ::: "memory");
            load_raw(raw, 2 * u.pm, g * 256 + 32 * wc, wr, fr, fq);
#pragma unroll
            for (int m = 0; m < 4; ++m) un[m] = *(const u32x4*)(U + ((size_t)(2 * u.pm) * 128 + 64 * wr + 16 * m + fr) * AW + g * 256 + 32 * wc + 8 * fq);
            asm volatile("" ::: "memory");
#pragma unroll
            for (int blk = 1; blk < 4; ++blk)
#pragma unroll
                for (int m = 0; m < 4; ++m) { const float r_ = (blk >> 1) ? rs1[m] : rs0[m]; const f32x4 z0 = acc[blk >> 1][blk & 1][m][0] * r_, z1 = acc[blk >> 1][blk & 1][m][1] * r_;
                    zs[blk - 1][m].x = cvt_pk_bf16(silu_f(z0.x), silu_f(z0.y)); zs[blk - 1][m].y = cvt_pk_bf16(silu_f(z0.z), silu_f(z0.w));
                    zs[blk - 1][m].z = cvt_pk_bf16(silu_f(z1.x), silu_f(z1.y)); zs[blk - 1][m].w = cvt_pk_bf16(silu_f(z1.z), silu_f(z1.w)); }
        }
#pragma unroll
        for (int blk = 0; blk < 4; ++blk) {
            const int ai = blk >> 1, bj = blk & 1;
            const int chunk = 2 * u.pm + ai; const size_t tok0 = (size_t)chunk * 128;
            const int cb = g * 256 + 128 * bj + 32 * wc;
            int fr = fr_in, fq = fq_in; asm volatile("" : "+v"(fr), "+v"(fq));
            u32x4 uu[4], vf[2][4]; float lg[2], lb[2];
#pragma unroll
            for (int m = 0; m < 4; ++m) uu[m] = un[m];
#pragma unroll
            for (int n = 0; n < 2; ++n) { lg[n] = lgn[n]; lb[n] = lbn[n]; }
#pragma unroll
            for (int k = 0; k < 4; ++k) { if (k <= 2 * wr + 1) { const int s = 32 * k + 8 * fq;
                const PG8_LAS float* sp = (const PG8_LAS float*)stc + ai * 128 + s;
                const f32x4 m0 = *(const PG8_LAS f32x4*)sp, m1 = *(const PG8_LAS f32x4*)(sp + 4), r0 = *(const PG8_LAS f32x4*)(sp + 256), r1 = *(const PG8_LAS f32x4*)(sp + 260);
#pragma unroll
                for (int n = 0; n < 2; ++n) { const u32x4 rw = raw[n][k]; const float g_ = lg[n], b_ = lb[n]; u32x4 o;
                    o.x = cvt_pk_bf16((bflo(rw.x) * r0.x + m0.x) * g_ + b_, (bfhi(rw.x) * r0.y + m0.y) * g_ + b_);
                    o.y = cvt_pk_bf16((bflo(rw.y) * r0.z + m0.z) * g_ + b_, (bfhi(rw.y) * r0.w + m0.w) * g_ + b_);
                    o.z = cvt_pk_bf16((bflo(rw.z) * r1.x + m1.x) * g_ + b_, (bfhi(rw.z) * r1.y + m1.y) * g_ + b_);
                    o.w = cvt_pk_bf16((bflo(rw.w) * r1.z + m1.z) * g_ + b_, (bfhi(rw.w) * r1.w + m1.w) * g_ + b_);
                    vf[n][k] = o; } } }
            asm volatile("" ::: "memory");
            if (blk < 3) { const int nb = blk + 1; load_raw(raw, 2 * u.pm + (nb >> 1), g * 256 + 128 * (nb & 1) + 32 * wc, wr, fr, fq);
#pragma unroll
                for (int m = 0; m < 4; ++m) un[m] = *(const u32x4*)(U + ((size_t)(2 * u.pm + (nb >> 1)) * 128 + 64 * wr + 16 * m + fr) * AW + g * 256 + 128 * (nb & 1) + 32 * wc + 8 * fq);
#pragma unroll
                for (int n = 0; n < 2; ++n) { const int ch = g * 256 + 128 * (nb & 1) + 32 * wc + 8 * (fr >> 2) + 4 * n + (fr & 3); lgn[n] = lng[ch]; lbn[n] = lnb[ch]; } }
            asm volatile("" ::: "memory");
#pragma unroll
            for (int m = 0; m < 4; ++m) {
                const int m8 = 4 * wr + m, p = m8 >> 1, kmax = p, fbase = (p + 1) * (p + (m8 & 1));
                const PG8_LAS unsigned char* wp = wl + fbase * 1280 + fr * 80 + fq * 16;
                f32x4 s0 = (f32x4){0.f, 0.f, 0.f, 0.f}, s1 = (f32x4){0.f, 0.f, 0.f, 0.f};
#pragma unroll
                for (int k = 0; k < 4; ++k) { if (k <= kmax) { const bf16x8 wf = *(const PG8_LAS bf16x8*)(wp + k * 1280);
                    s0 = __builtin_amdgcn_mfma_f32_16x16x32_bf16(__builtin_bit_cast(bf16x8, vf[0][k]), wf, s0, 0, 0, 0);
                    s1 = __builtin_amdgcn_mfma_f32_16x16x32_bf16(__builtin_bit_cast(bf16x8, vf[1][k]), wf, s1, 0, 0, 0); } }
                const float b_ = bs[m]; const u32x4 ux = uu[m];
                f32x4 g0, g1;
                if (blk == 0) { const f32x4 z0 = acc[0][0][m][0] * rs0[m], z1 = acc[0][0][m][1] * rs0[m];
                    g0 = (f32x4){silu_f(z0.x), silu_f(z0.y), silu_f(z0.z), silu_f(z0.w)}; g1 = (f32x4){silu_f(z1.x), silu_f(z1.y), silu_f(z1.z), silu_f(z1.w)}; }
                else { const u32x4 zz = zs[blk - 1][m]; g0 = (f32x4){bflo(zz.x), bfhi(zz.x), bflo(zz.y), bfhi(zz.y)}; g1 = (f32x4){bflo(zz.z), bfhi(zz.z), bflo(zz.w), bfhi(zz.w)}; }
                u32x4 o;
                o.x = cvt_pk_bf16(bflo(ux.x) * (s0.x + b_) * g0.x, bfhi(ux.x) * (s0.y + b_) * g0.y);
                o.y = cvt_pk_bf16(bflo(ux.y) * (s0.z + b_) * g0.z, bfhi(ux.y) * (s0.w + b_) * g0.w);
                o.z = cvt_pk_bf16(bflo(ux.z) * (s1.x + b_) * g1.x, bfhi(ux.z) * (s1.y + b_) * g1.y);
                o.w = cvt_pk_bf16(bflo(ux.w) * (s1.z + b_) * g1.z, bfhi(ux.w) * (s1.w + b_) * g1.w);
                *(u32x4*)(U + (tok0 + 64 * wr + 16 * m + fr) * AW + cb + 8 * fq) = o;
            }
        }
        { const int tid = (wr * 4 + wc) * 64 + fq_in * 16 + fr_in; ((PG8_LAS float*)stn)[tid] = stnext; }
    }
};
struct EpiY16 {
    static constexpr bool PERM = true, AFTER_DRAIN = false;
    bf16_t* C; int ldc;
    __device__ __forceinline__ void operator()(const f32x4 (&acc)[2][2][4][2], const Unit& u, int wr, int wc, int fr, int fq) const {
        const int row0 = u.pm * BM + wr * 64 + fr, col0 = u.pn * BM + wc * 32 + 8 * fq;
#pragma unroll
        for (int ai = 0; ai < 2; ++ai)
#pragma unroll
            for (int m = 0; m < 4; ++m) { bf16_t* rowp = C + (size_t)(row0 + ai * HALF + m * 16) * ldc + col0;
#pragma unroll
                for (int bj = 0; bj < 2; ++bj) { const f32x4 v0 = acc[ai][bj][m][0], v1 = acc[ai][bj][m][1];
                    u32x4 w; w.x = cvt_pk_bf16(v0[0], v0[1]); w.y = cvt_pk_bf16(v0[2], v0[3]); w.z = cvt_pk_bf16(v1[0], v1[1]); w.w = cvt_pk_bf16(v1[2], v1[3]);
                    __builtin_nontemporal_store(w, (u32x4*)(rowp + bj * HALF)); } }
    }
};
}

struct Args {
    const float* x; const float* a_w_in; const float* a_ln_g; const float* a_ln_b; const float* a_w_s; const float* a_b_s; const float* a_w_out;
    const float* a_pre_g; const float* a_post_g; const float* kv_norm_g; const float* w_k; const float* w_v; const float* b_w_in; const float* b_sinks;
    const float* b_w_out; const float* b_pre_g; const float* b_post_g;
    float* out; unsigned char* ws;
};

__device__ __forceinline__ void transpose_item(const float* W, int ldw, int col0, int K, bf16* WT, int row_off, int nblk, const float* gv, float mult, LAS float* scr, int item, int lane) {
    const int kb = item / nblk, nb = item % nblk, k0 = 64 * kb, n0 = 32 * nb;
    float wv[32], gg[32];
#pragma unroll
    for (int i = 0; i < 32; ++i) { const int kk = 2 * i + (lane >> 5); wv[i] = W[(size_t)(k0 + kk) * ldw + col0 + n0 + (lane & 31)]; gg[i] = gv ? gv[k0 + kk] : 1.0f; }
#pragma unroll
    for (int i = 0; i < 32; ++i) { const int kk = 2 * i + (lane >> 5); scr[kk * 33 + (lane & 31)] = wv[i] * (gg[i] * mult); }
    asm volatile("s_waitcnt lgkmcnt(0)" ::: "memory");
    const int c = lane & 7;
#pragma unroll
    for (int j = 0; j < 4; ++j) { const int n = (lane >> 3) + 8 * j; const LAS float* s = scr + (8 * c) * 33 + n;
        v4u o; o.x = pk2(s[0 * 33], s[1 * 33]); o.y = pk2(s[2 * 33], s[3 * 33]); o.z = pk2(s[4 * 33], s[5 * 33]); o.w = pk2(s[6 * 33], s[7 * 33]);
        *(v4u*)(WT + (size_t)(row_off + n0 + n) * K + k0 + 8 * c) = o; }
    asm volatile("s_waitcnt lgkmcnt(0)" ::: "memory");
}

__device__ __forceinline__ void p0_prologue(const Args& a, LAS unsigned char* lds, int gw, int NGW, int wave, int lane) {
    LAS float* scr = (LAS float*)(lds + wave * 16384);
    bf16* ws_wa_in = (bf16*)(a.ws + WS_WA_IN); bf16* ws_wa_out = (bf16*)(a.ws + WS_WA_OUT);
    bf16* ws_wb_in0 = (bf16*)(a.ws + WS_WB_IN0); bf16* ws_wb_in1 = (bf16*)(a.ws + WS_WB_IN1); bf16* ws_wb_out = (bf16*)(a.ws + WS_WB_OUT);
    constexpr int I_AIN = 16 * 64;
    constexpr int I_AOUT = 32 * 32;
    constexpr int I_BIN = 16 * 32;
    constexpr int I_KV = 16 * 8;
    constexpr int I_BOUT = 16 * 32;
    constexpr int NITEMS = 6 * I_AIN + 2 * I_AOUT + 4 * I_BIN + 2 * I_KV + 2 * I_BOUT;
    for (int it = gw; it < NITEMS; it += NGW) {
        int r = it;
        if (r < 6 * I_AIN) { const int l = r / (3 * I_AIN), part = (r / I_AIN) % 3, item = r % I_AIN;
            const int col0 = part == 0 ? 0 : (part == 1 ? 4096 : 2048);
            transpose_item(a.a_w_in + (size_t)l * 1024 * 6144, 6144, col0, 1024, ws_wa_in + (size_t)l * 6144 * 1024, part * 2048, 64, a.a_pre_g + l * 1024, 1.0f, scr, item, lane); continue; }
        r -= 6 * I_AIN;
        if (r < 2 * I_AOUT) { const int l = r / I_AOUT, item = r % I_AOUT;
            transpose_item(a.a_w_out + (size_t)l * 2048 * 1024, 1024, 0, 2048, ws_wa_out + (size_t)l * 1024 * 2048, 0, 32, nullptr, 1.0f, scr, item, lane); continue; }
        r -= 2 * I_AOUT;
        if (r < 4 * I_BIN) { const int l = r / (2 * I_BIN), part = (r / I_BIN) & 1, item = r % I_BIN;
            transpose_item(a.b_w_in + (size_t)l * 1024 * 2048, 2048, part * 1024, 1024, l ? ws_wb_in1 : ws_wb_in0, part * 1024, 32, a.b_pre_g + l * 1024, part == 0 ? 0.125f : 1.0f, scr, item, lane); continue; }
        r -= 4 * I_BIN;
        if (r < 2 * I_KV) { const int part = r / I_KV, item = r % I_KV;
            transpose_item(part ? a.w_v : a.w_k, 256, 0, 1024, ws_wb_in0, 2048 + part * 256, 8, a.kv_norm_g, 1.0f, scr, item, lane); continue; }
        r -= 2 * I_KV;
        { const int l = r / I_BOUT, item = r % I_BOUT;
            transpose_item(a.b_w_out + (size_t)l * 1024 * 1024, 1024, 0, 1024, ws_wb_out + (size_t)l * 1024 * 1024, 0, 32, nullptr, 1.0f, scr, item, lane); }
    }
    { bf16* W16 = (bf16*)(a.ws + WS_W16); const int gt = gw * 64 + lane, NT = NGW * 64;
      for (int i = gt; i < 2 * 8 * 128 * 16; i += NT) { const int t = (i >> 4) & 127, s = (i & 15) * 8; const float* src = a.a_w_s + (size_t)i * 8;
          const f32x4 w0 = *(const f32x4*)src, w1 = *(const f32x4*)(src + 4); v4u o;
          o.x = pk2(s + 0 <= t ? w0.x : 0.f, s + 1 <= t ? w0.y : 0.f); o.y = pk2(s + 2 <= t ? w0.z : 0.f, s + 3 <= t ? w0.w : 0.f);
          o.z = pk2(s + 4 <= t ? w1.x : 0.f, s + 5 <= t ? w1.y : 0.f); o.w = pk2(s + 6 <= t ? w1.z : 0.f, s + 7 <= t ? w1.w : 0.f);
          *(v4u*)(W16 + (size_t)i * 8) = o; } }
    bf16* HN = (bf16*)(a.ws + WS_HN); float* RINV = (float*)(a.ws + WS_RINV);
    for (int mb = gw * 4; mb < M; mb += NGW * 4) {
        f32x4 v[4][4];
#pragma unroll
        for (int r = 0; r < 4; ++r) { const f32x4* xr = (const f32x4*)(a.x + (size_t)(mb + r) * D) + lane;
#pragma unroll
            for (int j = 0; j < 4; ++j) v[r][j] = xr[64 * j]; }
#pragma unroll
        for (int r = 0; r < 4; ++r) { v2u o[4]; float s = 0.f;
#pragma unroll
            for (int j = 0; j < 4; ++j) { o[j].x = pk2(v[r][j].x, v[r][j].y); o[j].y = pk2(v[r][j].z, v[r][j].w);
                const float a0 = bflo(o[j].x), a1 = bfhi(o[j].x), a2 = bflo(o[j].y), a3 = bfhi(o[j].y); s += (a0 * a0 + a1 * a1) + (a2 * a2 + a3 * a3); }
            const float rr = __builtin_amdgcn_rsqf(wave_sum(s) * (1.f / D) + EPS);
            v2u* o8 = (v2u*)(HN + (size_t)(mb + r) * D) + lane;
#pragma unroll
            for (int j = 0; j < 4; ++j) o8[64 * j] = o[j];
            if (lane == 0) RINV[mb + r] = rr; }
    }
}

__device__ __forceinline__ void row_phase(const bf16* Y, bf16* H, const float* post_g, float* RINV, float* out_final, int gw, int NGW, int lane) {
    f32x4 g[4];
#pragma unroll
    for (int j = 0; j < 4; ++j) g[j] = ((const f32x4*)post_g)[lane + 64 * j];
    for (int mb = gw * 4; mb < M; mb += NGW * 4) {
        v2u yw[4][4], hw[4][4];
#pragma unroll
        for (int r = 0; r < 4; ++r) { const v2u* yr = (const v2u*)(Y + (size_t)(mb + r) * D) + lane; const v2u* hr = (const v2u*)(H + (size_t)(mb + r) * D) + lane;
#pragma unroll
            for (int j = 0; j < 4; ++j) { yw[r][j] = yr[64 * j]; hw[r][j] = hr[64 * j]; } }
#pragma unroll
        for (int r = 0; r < 4; ++r) { const int m = mb + r;
            f32x4 y[4]; float s = 0.f;
#pragma unroll
            for (int j = 0; j < 4; ++j) { y[j] = (f32x4){bflo(yw[r][j].x), bfhi(yw[r][j].x), bflo(yw[r][j].y), bfhi(yw[r][j].y)}; s += (y[j].x * y[j].x + y[j].y * y[j].y) + (y[j].z * y[j].z + y[j].w * y[j].w); }
            const float r1 = __builtin_amdgcn_rsqf(wave_sum(s) * (1.f / D) + EPS);
            if (out_final) {
                f32x4* ho = (f32x4*)(out_final + (size_t)m * D) + lane;
#pragma unroll
                for (int j = 0; j < 4; ++j) { const f32x4 h = (f32x4){bflo(hw[r][j].x), bfhi(hw[r][j].x), bflo(hw[r][j].y), bfhi(hw[r][j].y)}; ho[64 * j] = h + y[j] * r1 * g[j]; }
            } else {
                float s2 = 0.f; v2u* hr = (v2u*)(H + (size_t)m * D) + lane;
#pragma unroll
                for (int j = 0; j < 4; ++j) { const f32x4 h = (f32x4){bflo(hw[r][j].x), bfhi(hw[r][j].x), bflo(hw[r][j].y), bfhi(hw[r][j].y)}; const f32x4 hn = h + y[j] * r1 * g[j];
                    v2u o; o.x = pk2(hn.x, hn.y); o.y = pk2(hn.z, hn.w); hr[64 * j] = o;
                    const float a0 = bflo(o.x), a1 = bfhi(o.x), a2 = bflo(o.y), a3 = bfhi(o.y); s2 += (a0 * a0 + a1 * a1) + (a2 * a2 + a3 * a3); }
                const float r2 = __builtin_amdgcn_rsqf(wave_sum(s2) * (1.f / D) + EPS);
                if (lane == 0) RINV[m] = r2;
            }
        }
    }
}

constexpr int WL_STRIDE = 136;
constexpr int GATE_MAXCH = 32;
__device__ __forceinline__ void gate_phase(const Args& a, int layer, LAS unsigned char* lds, int G, int tid, int wave, int lane) {
    LAS bf16* Wl = (LAS bf16*)lds;
    LAS float* mu_l = (LAS float*)(lds + 128 * WL_STRIDE * 2);
    LAS float* rs_l = mu_l + GATE_MAXCH * 128;
    bf16* U = (bf16*)(a.ws + WS_U); const bf16* Z = (const bf16*)(a.ws + WS_Z); const bf16* VT = (const bf16*)(a.ws + WS_VT);
    const float* ssum = (const float*)(a.ws + WS_STAT); const float* ssq = ssum + (size_t)16 * M;
    const int fr = lane & 15, fq = lane >> 4;
    const int g = blockIdx.x & 7, c0 = blockIdx.x >> 3, cstep = G >> 3;
    {
        const int t = tid >> 2, s0 = (tid & 3) * 32; const float* wsrc = a.a_w_s + (((size_t)layer * 8 + g) * CH + t) * CH + s0;
#pragma unroll
        for (int j = 0; j < 4; ++j) { const f32x4 w0 = *(const f32x4*)(wsrc + 8 * j), w1 = *(const f32x4*)(wsrc + 8 * j + 4); const int s = s0 + 8 * j;
            v4u o; o.x = pk2(s + 0 <= t ? w0.x : 0.f, s + 1 <= t ? w0.y : 0.f); o.y = pk2(s + 2 <= t ? w0.z : 0.f, s + 3 <= t ? w0.w : 0.f);
            o.z = pk2(s + 4 <= t ? w1.x : 0.f, s + 5 <= t ? w1.y : 0.f); o.w = pk2(s + 6 <= t ? w1.z : 0.f, s + 7 <= t ? w1.w : 0.f);
            *(LAS v4u*)(Wl + t * WL_STRIDE + s) = o; }
    }
    {
        int ci = 0;
        for (int chunk = c0; chunk < 512; chunk += cstep, ++ci) {
            if (tid < CH) { const size_t tok = (size_t)chunk * CH + tid; float s = 0.f, q = 0.f;
#pragma unroll
                for (int k = 0; k < 16; ++k) { s += ssum[(size_t)k * M + tok]; q += ssq[(size_t)k * M + tok]; }
                const float mu = s * (1.f / AW); const float var = fmaxf(q * (1.f / AW) - mu * mu, 0.f);
                mu_l[ci * 128 + tid] = mu; rs_l[ci * 128 + tid] = __builtin_amdgcn_rsqf(var + EPS); }
        }
    }
    __syncthreads();
    const int cb = g * 256 + wave * 32;
    float lg[2], lb[2];
#pragma unroll
    for (int n = 0; n < 2; ++n) { const int ch = cb + 8 * (fr >> 2) + 4 * n + (fr & 3); lg[n] = a.a_ln_g[layer * AW + ch]; lb[n] = a.a_ln_b[layer * AW + ch]; }
    const float* bsrc = a.a_b_s + ((size_t)layer * 8 + g) * CH;
    float bs[8];
#pragma unroll
    for (int mb = 0; mb < 8; ++mb) bs[mb] = bsrc[16 * mb + fr];
    int ci = 0;
    for (int chunk = c0; chunk < 512; chunk += cstep, ++ci) {
        const size_t tok0 = (size_t)chunk * CH;
        v4u raw[2][4], u8[8], z8[8];
#pragma unroll
        for (int n = 0; n < 2; ++n) { const int ch = cb + 8 * (fr >> 2) + 4 * n + (fr & 3);
#pragma unroll
            for (int k = 0; k < 4; ++k) raw[n][k] = *(const v4u*)(VT + ((size_t)chunk * AW + ch) * 128 + 32 * k + 8 * fq); }
#pragma unroll
        for (int mb = 0; mb < 8; ++mb) { const size_t off = (tok0 + 16 * mb + fr) * AW + cb + 8 * fq; u8[mb] = *(const v4u*)(U + off); z8[mb] = *(const v4u*)(Z + off); }
        bf16x8 bfr[2][4];
#pragma unroll
        for (int k = 0; k < 4; ++k) { const int s = 32 * k + 8 * fq;
            const f32x4 m0 = *(LAS f32x4*)(mu_l + ci * 128 + s), m1 = *(LAS f32x4*)(mu_l + ci * 128 + s + 4), r0 = *(LAS f32x4*)(rs_l + ci * 128 + s), r1 = *(LAS f32x4*)(rs_l + ci * 128 + s + 4);
#pragma unroll
            for (int n = 0; n < 2; ++n) { const v4u rw = raw[n][k]; const float g_ = lg[n], b_ = lb[n];
                v4u o;
                o.x = pk2((bflo(rw.x) - m0.x) * r0.x * g_ + b_, (bfhi(rw.x) - m0.y) * r0.y * g_ + b_);
                o.y = pk2((bflo(rw.y) - m0.z) * r0.z * g_ + b_, (bfhi(rw.y) - m0.w) * r0.w * g_ + b_);
                o.z = pk2((bflo(rw.z) - m1.x) * r1.x * g_ + b_, (bfhi(rw.z) - m1.y) * r1.y * g_ + b_);
                o.w = pk2((bflo(rw.w) - m1.z) * r1.z * g_ + b_, (bfhi(rw.w) - m1.w) * r1.w * g_ + b_);
                bfr[n][k] = __builtin_bit_cast(bf16x8, o); } }
#pragma unroll
        for (int mb = 0; mb < 8; ++mb) {
            f32x4 acc0 = (f32x4){0.f, 0.f, 0.f, 0.f}, acc1 = (f32x4){0.f, 0.f, 0.f, 0.f};
            const int t = 16 * mb + fr;
#pragma unroll
            for (int k = 0; k < 4; ++k) { if (k <= (mb >> 1)) {
                const bf16x8 af = *(LAS bf16x8*)(Wl + t * WL_STRIDE + 32 * k + 8 * fq);
                acc0 = __builtin_amdgcn_mfma_f32_16x16x32_bf16(bfr[0][k], af, acc0, 0, 0, 0);
                acc1 = __builtin_amdgcn_mfma_f32_16x16x32_bf16(bfr[1][k], af, acc1, 0, 0, 0); } }
            const v4u uu = u8[mb], zz = z8[mb]; const float b_ = bs[mb];
            v4u o;
            o.x = pk2(bflo(uu.x) * (acc0.x + b_) * bflo(zz.x), bfhi(uu.x) * (acc0.y + b_) * bfhi(zz.x));
            o.y = pk2(bflo(uu.y) * (acc0.z + b_) * bflo(zz.y), bfhi(uu.y) * (acc0.w + b_) * bfhi(zz.y));
            o.z = pk2(bflo(uu.z) * (acc1.x + b_) * bflo(zz.z), bfhi(uu.z) * (acc1.y + b_) * bfhi(zz.z));
            o.w = pk2(bflo(uu.w) * (acc1.z + b_) * bflo(zz.w), bfhi(uu.w) * (acc1.w + b_) * bfhi(zz.w));
            *(v4u*)(U + (tok0 + t) * AW + cb + 8 * fq) = o;
        }
    }
    __syncthreads();
}

constexpr int AT_KSTR = 144, AT_VSTR = 528, AT_VOFF = 256 * AT_KSTR;
__device__ __forceinline__ void attn_load_tiles(const bf16* KB, const bf16* VTB, int it, int tid, v4u (&kr)[4], v4u (&vr)[4]) {
    const int kvh = it & 3, qi = (it >> 2) & 31, b = it >> 7;
    const long tokb = (long)b * SEQ + (long)qi * 128; const int gb = b * 32 + qi;
#pragma unroll
    for (int j = 0; j < 4; ++j) { const int c = tid + 512 * j;
        { const int row = c >> 3, part = c & 7;
          kr[j] = (qi == 0 && row < 128) ? (v4u){0u, 0u, 0u, 0u} : *(const v4u*)(KB + (size_t)(tokb - 128 + row) * 256 + kvh * 64 + part * 8); }
        { const int dd = c >> 5, half = (c >> 4) & 1, part = c & 15;
          vr[j] = (qi == 0 && half == 0) ? (v4u){0u, 0u, 0u, 0u} : *(const v4u*)(VTB + ((size_t)(gb - 1 + half) * 256 + kvh * 64 + dd) * 128 + part * 8); } }
}
__device__ __forceinline__ void attn_phase(const Args& a, int layer, LAS unsigned char* lds, int G, int tid, int wave, int lane) {
    bf16* Q = (bf16*)(a.ws + WS_U); const bf16* ZG = Q + (size_t)M * D;
    const bf16* KB = (const bf16*)(a.ws + WS_Z); const bf16* VTB = KB + (size_t)M * 256;
    const int fr = lane & 15, fq = lane >> 4;
    v4u kr[4], vr[4];
    if ((int)blockIdx.x < 2048) attn_load_tiles(KB, VTB, blockIdx.x, tid, kr, vr);
    for (int it = blockIdx.x; it < 2048; it += G) {
        const int kvh = it & 3, qi = (it >> 2) & 31, b = it >> 7;
        const int h = kvh * 4 + (wave >> 1);
        const float slope = __builtin_amdgcn_exp2f(-0.5f * (float)(h + 1)) * LOG2E;
        const float sink = a.b_sinks[layer * 16 + h] * LOG2E;
        const long tokb = (long)b * SEQ + (long)qi * 128;
        bf16x8 qf[4][2];
#pragma unroll
        for (int mb = 0; mb < 4; ++mb) { const size_t qrow = (size_t)(tokb + (wave & 1) * 64 + 16 * mb + fr) * D + h * 64;
            qf[mb][0] = *(const bf16x8*)(Q + qrow + 8 * fq); qf[mb][1] = *(const bf16x8*)(Q + qrow + 8 * fq + 32); }
        f32x4 bias0, bias8; const float b0 = -slope * (float)(128 + fr - 4 * fq);
#pragma unroll
        for (int e = 0; e < 4; ++e) { const int d0 = 128 + fr - 4 * fq - e, d8 = fr - 4 * fq - e; bias0[e] = d0 < 128 ? -slope * (float)d0 : -INFINITY; bias8[e] = d8 >= 0 ? -slope * (float)d8 : -INFINITY; }
        __syncthreads();
#pragma unroll
        for (int j = 0; j < 4; ++j) { const int c = tid + 512 * j;
            *(LAS v4u*)(lds + (c >> 3) * AT_KSTR + (c & 7) * 16) = kr[j];
            *(LAS v4u*)(lds + AT_VOFF + (c >> 5) * AT_VSTR + (((c >> 4) & 1) * 128 + (c & 15) * 8) * 2) = vr[j]; }
        __syncthreads();
        if (it + G < 2048) attn_load_tiles(KB, VTB, it + G, tid, kr, vr);
#pragma unroll
        for (int mb = 0; mb < 4; ++mb) {
            const int t0 = (wave & 1) * 64 + 16 * mb, nb0 = t0 >> 4;
            const size_t orow = (size_t)(tokb + t0 + fr) * D + h * 64 + 4 * fq;
            v2u zz[4];
#pragma unroll
            for (int db = 0; db < 4; ++db) zz[db] = *(const v2u*)(ZG + orow + 16 * db);
            f32x4 S[10];
            const LAS unsigned char* kbase = lds + (16 * nb0 + fr) * AT_KSTR + 16 * fq;
#pragma unroll
            for (int nb = 0; nb < 9; ++nb) {
                const bf16x8 kf0 = *(const LAS bf16x8*)(kbase + nb * 16 * AT_KSTR), kf1 = *(const LAS bf16x8*)(kbase + nb * 16 * AT_KSTR + 64);
                f32x4 z = (f32x4){0.f, 0.f, 0.f, 0.f};
                z = __builtin_amdgcn_mfma_f32_16x16x32_bf16(kf0, qf[mb][0], z, 0, 0, 0);
                S[nb] = __builtin_amdgcn_mfma_f32_16x16x32_bf16(kf1, qf[mb][1], z, 0, 0, 0); }
            float mx = sink;
#pragma unroll
            for (int nb = 0; nb < 9; ++nb)
#pragma unroll
                for (int e = 0; e < 4; ++e) S[nb][e] = nb == 0 ? S[nb][e] * LOG2E + bias0[e] : (nb == 8 ? S[nb][e] * LOG2E + bias8[e] : (S[nb][e] * LOG2E + b0) + slope * (float)(16 * nb + e));
            if (qi == 0) {
#pragma unroll
                for (int nb = 0; nb < 9; ++nb)
#pragma unroll
                    for (int e = 0; e < 4; ++e) { const int c = 16 * (nb0 + nb) + 4 * fq + e; S[nb][e] = c >= 128 ? S[nb][e] : -INFINITY; }
            }
#pragma unroll
            for (int nb = 0; nb < 9; ++nb)
#pragma unroll
                for (int e = 0; e < 4; ++e) mx = fmaxf(mx, S[nb][e]);
            mx = fmaxf(mx, __shfl_xor(mx, 16)); mx = fmaxf(mx, __shfl_xor(mx, 32));
            float den = 0.f;
#pragma unroll
            for (int nb = 0; nb < 9; ++nb)
#pragma unroll
                for (int e = 0; e < 4; ++e) { const float p = __builtin_amdgcn_exp2f(S[nb][e] - mx); S[nb][e] = p; den += p; }
            den += __shfl_xor(den, 16); den += __shfl_xor(den, 32);
            den += __builtin_amdgcn_exp2f(sink - mx);
            S[9] = (f32x4){0.f, 0.f, 0.f, 0.f};
            f32x4 O[4];
#pragma unroll
            for (int db = 0; db < 4; ++db) O[db] = (f32x4){0.f, 0.f, 0.f, 0.f};
#pragma unroll
            for (int kk = 0; kk < 5; ++kk) {
                v4u pw; pw.x = pk2(S[2 * kk][0], S[2 * kk][1]); pw.y = pk2(S[2 * kk][2], S[2 * kk][3]); pw.z = pk2(S[2 * kk + 1][0], S[2 * kk + 1][1]); pw.w = pk2(S[2 * kk + 1][2], S[2 * kk + 1][3]);
                const bf16x8 pb = __builtin_bit_cast(bf16x8, pw);
                int kb0 = nb0 + 2 * kk, kb1 = kb0 + 1; if (kb0 > 15) kb0 = 15; if (kb1 > 15) kb1 = 15;
#pragma unroll
                for (int db = 0; db < 4; ++db) { const LAS unsigned char* vp = lds + AT_VOFF + (16 * db + fr) * AT_VSTR + 8 * fq;
                    v4u vw; const v2u v0 = *(const LAS v2u*)(vp + 32 * kb0), v1 = *(const LAS v2u*)(vp + 32 * kb1); vw.x = v0.x; vw.y = v0.y; vw.z = v1.x; vw.w = v1.y;
                    O[db] = __builtin_amdgcn_mfma_f32_16x16x32_bf16(__builtin_bit_cast(bf16x8, vw), pb, O[db], 0, 0, 0); } }
            const float inv = __builtin_amdgcn_rcpf(den);
#pragma unroll
            for (int db = 0; db < 4; ++db) {
                v2u o; o.x = pk2(O[db][0] * inv * bflo(zz[db].x), O[db][1] * inv * bfhi(zz[db].x)); o.y = pk2(O[db][2] * inv * bflo(zz[db].y), O[db][3] * inv * bfhi(zz[db].y));
                *(v2u*)(Q + orow + 16 * db) = o; }
        }
    }
    __syncthreads();
}

#define XB_TMO      128
#define XB_XCNT(j)  (256  + 64 * (j))
#define XB_XSUB(j)  (1280 + 64 * (j))
#define XB_XGEN(j)  (2304 + 64 * (j))
#define XB_TOP      3328
#define XB_TOPGEN   3392
#define XCD_BAR_WORDS 3456
#define XB_SPIN_CAP (1u << 18)

__device__ __forceinline__ unsigned xb_ld(unsigned* p)              { return __hip_atomic_load(p, __ATOMIC_RELAXED, __HIP_MEMORY_SCOPE_AGENT); }
__device__ __forceinline__ unsigned xb_add(unsigned* p, unsigned v) { return __hip_atomic_fetch_add(p, v, __ATOMIC_RELAXED, __HIP_MEMORY_SCOPE_AGENT); }
__device__ __forceinline__ unsigned xb_xcc_id() { return (unsigned)__builtin_amdgcn_s_getreg((3 << 11) | 20) & 0xFu; }
#define XB_SPIN(cond, bar) do { unsigned _sp = 0; while (cond) { __builtin_amdgcn_s_sleep(1); \
    if ((++_sp & 255u) == 0u) { if (xb_ld(&(bar)[XB_TMO])) break; if (_sp > XB_SPIN_CAP) { atomicAdd(&(bar)[XB_TMO], 1u); break; } } } } while (0)

struct XcdBarrier {
    unsigned* bar; unsigned x;
    volatile LAS unsigned* st;
};

__device__ __forceinline__ XcdBarrier xcd_barrier_post(unsigned* bar, volatile LAS unsigned* st) {
    XcdBarrier b; b.bar = bar; b.x = xb_xcc_id(); b.st = st;
    if (threadIdx.x == 0) (void)xb_add(&bar[XB_XCNT(b.x)], 1u);
    return b;
}
__device__ __forceinline__ void xcd_barrier_complete(unsigned* bar, unsigned x, unsigned& nloc, unsigned& nx) {
    const unsigned G = gridDim.x * gridDim.y * gridDim.z;
    unsigned sum, cnt, mine, sp = 0u;
    for (;;) {
        sum = 0u; cnt = 0u; mine = 0u;
#pragma unroll
        for (unsigned j = 0; j < 16; ++j) { const unsigned c = xb_ld(&bar[XB_XCNT(j)]); sum += c; cnt += (c > 0u) ? 1u : 0u; mine = (j == x) ? c : mine; }
        if (sum == G) break;
        __builtin_amdgcn_s_sleep(1);
        if ((++sp & 255u) == 0u) { if (xb_ld(&bar[XB_TMO])) break; if (sp > XB_SPIN_CAP) { atomicAdd(&bar[XB_TMO], 1u); break; } }
    }
    nloc = mine > 0u ? mine : 1u; nx = cnt > 0u ? cnt : 1u;
}

__device__ __forceinline__ void xcd_barrier(const XcdBarrier& b) {
    asm volatile("s_waitcnt vmcnt(0)" ::: "memory");
    __syncthreads();
    if (threadIdx.x == 0) {
        unsigned* bar = b.bar; asm volatile("" : "+s"(bar));
        __builtin_amdgcn_s_waitcnt(0);
        unsigned nloc = b.st[0], nx = b.st[1];
        if (nloc == 0u) { xcd_barrier_complete(bar, b.x, nloc, nx); b.st[0] = nloc; b.st[1] = nx; }
        const unsigned old = xb_add(&bar[XB_XSUB(b.x)], 1u);
        const unsigned gen = old / nloc;
        if (old + 1u == (gen + 1u) * nloc) {
            __builtin_amdgcn_fence(__ATOMIC_RELEASE, "agent");
            asm volatile("s_waitcnt vmcnt(0)" ::: "memory");
            const unsigned og = xb_add(&bar[XB_TOP], 1u);
            const unsigned tg = og / nx;
            if (og + 1u == (tg + 1u) * nx) xb_add(&bar[XB_TOPGEN], 1u);
            else XB_SPIN(xb_ld(&bar[XB_TOPGEN]) == tg, bar);
            __builtin_amdgcn_fence(__ATOMIC_ACQUIRE, "agent");
            xb_add(&bar[XB_XGEN(b.x)], 1u);
            asm volatile("s_waitcnt vmcnt(0)" ::: "memory");
        } else {
            XB_SPIN(xb_ld(&bar[XB_XGEN(b.x)]) == gen, bar);
            __builtin_amdgcn_fence(__ATOMIC_ACQUIRE, "agent");
            asm volatile("s_waitcnt vmcnt(0)" ::: "memory");
        }
    }
    __syncthreads();
}


__global__ void __launch_bounds__(NWAVES * 64, 2) yoco_fwd(Args a) {
    extern __shared__ __attribute__((aligned(16))) unsigned char lds_raw[];
    LAS unsigned char* lds = (LAS unsigned char*)lds_raw;
    cg::grid_group grid = cg::this_grid();
    if (threadIdx.x < 2) ((volatile LAS unsigned*)(lds + LDS_MISC))[threadIdx.x] = 0u;
    if (blockIdx.x == 0) { for (int i = threadIdx.x; i < XCD_BAR_WORDS; i += NWAVES * 64) ((unsigned*)a.ws + 4096)[i] = 0u; }
    __syncthreads();
#define GRID_BAR() xcd_barrier(xbar)
#define PHASE_IDS() int tid = threadIdx.x; asm volatile("" : "+v"(tid)); const int lane = tid & 63, wave = __builtin_amdgcn_readfirstlane(tid >> 6); const int gw = blockIdx.x * NWAVES + wave; (void)gw; (void)lane
    const int G = gridDim.x, NGW = G * NWAVES;
    bf16* HN = (bf16*)(a.ws + WS_HN);
    bf16* YOUT = (bf16*)(a.ws + WS_VT); float* RINV = (float*)(a.ws + WS_RINV);
#ifdef PROBE_A
    volatile LAS unsigned long long* tsl = (volatile LAS unsigned long long*)(lds + LDS_MISC + 64);
    int n_ts = 0;
#define STAMP() do { if (blockIdx.x == 0 && threadIdx.x == 0) tsl[n_ts] = __builtin_amdgcn_s_memrealtime(); ++n_ts; } while (0)
#else
#define STAMP() do {} while (0)
#endif
    STAMP();

    { PHASE_IDS(); p0_prologue(a, lds, gw, NGW, wave, lane); }
    grid.sync();
    const XcdBarrier xbar = xcd_barrier_post((unsigned*)a.ws + 4096, (volatile LAS unsigned*)(lds + LDS_MISC));
    STAMP();

    { constexpr int l = 0;
        const bf16* Win = (const bf16*)(a.ws + WS_WA_IN) + (size_t)l * 6144 * 1024;
        {
            pg8::Gemm g{HN, Win, M, AW, D}; pg8::StaticOrder S; S.init(M, AW, G, (int)blockIdx.x);
            pg8::EpiUZ E{(bf16*)(a.ws + WS_U), (bf16*)(a.ws + WS_Z), RINV};
            pg8::gemm_phase<pg8::EpiUZ, pg8::StaticOrder, true, true>(lds, g, S, E);
        }
        STAMP();
        {
            pg8::Gemm g{Win + (size_t)4096 * 1024, HN, AW, M, D}; pg8::StaticOrder S; S.init(AW, M, G, (int)blockIdx.x);
            pg8::EpiT<true> E{(bf16*)(a.ws + WS_VT), (float*)(a.ws + WS_STAT), (float*)(a.ws + WS_STAT) + (size_t)16 * M, AW, RINV};
            pg8::gemm_phase<pg8::EpiT<true>, pg8::StaticOrder, true, true>(lds, g, S, E);
        }
        GRID_BAR();
        STAMP();
        {
            PHASE_IDS(); const float* ssum = (const float*)(a.ws + WS_STAT); const float* ssq = ssum + (size_t)16 * M;
            for (int tok = blockIdx.x * 512 + tid; tok < M; tok += G * 512) { float s = 0.f, q = 0.f;
#pragma unroll
                for (int k = 0; k < 16; ++k) { s += ssum[(size_t)k * M + tok]; q += ssq[(size_t)k * M + tok]; }
                const float mu = s * (1.f / AW); const float var = fmaxf(q * (1.f / AW) - mu * mu, 0.f);
                const float rstd = __builtin_amdgcn_rsqf(var + EPS); ((float*)(a.ws + WS_MU))[tok] = -mu * rstd; ((float*)(a.ws + WS_RSTD))[tok] = rstd; }
        }
        GRID_BAR();
        {
            pg8::GroupOrder S{(int)blockIdx.x, G};
            {
                PHASE_IDS(); const int g = ((int)blockIdx.x >> 3) & 7; const bf16* W16 = (const bf16*)(a.ws + WS_W16) + ((size_t)l * 8 + g) * 128 * 128;
                for (int c = tid; c < 20 * 64; c += 512) { const int f = c >> 6, r = (c >> 2) & 15, part = c & 3;
                    int m8 = 0, fb = 0;
#pragma unroll
                    for (int j = 1; j < 8; ++j) { const int b = ((j >> 1) + 1) * ((j >> 1) + (j & 1)); if (f >= b) { m8 = j; fb = b; } }
                    const int k = f - fb;
                    *(LAS v4u*)(lds + LDS_WL + f * 1280 + r * 80 + part * 16) = *(const v4u*)(W16 + (size_t)(16 * m8 + r) * 128 + 32 * k + 8 * part); }
                { pg8::Unit u0; S.next(0, u0); ((LAS float*)(lds + LDS_ST))[tid] = ((const float*)(a.ws + (tid < 256 ? WS_MU : WS_RSTD)))[(size_t)u0.pm * 256 + (tid & 255)]; }
                __syncthreads();
            }
            pg8::Gemm g{HN, Win + (size_t)2048 * 1024, M, AW, D};
            pg8::EpiZGate E{(bf16*)(a.ws + WS_U), (const bf16*)(a.ws + WS_VT), RINV, (const float*)(a.ws + WS_MU), (const float*)(a.ws + WS_RSTD),
                            a.a_ln_g + l * AW, a.a_ln_b + l * AW, a.a_b_s + l * 8 * 128, lds + LDS_WL, lds + LDS_ST, (int)(blockIdx.x >> 6), G >> 6};
            pg8::gemm_phase<pg8::EpiZGate, pg8::GroupOrder, true, true>(lds, g, S, E);
        }
        GRID_BAR();
        STAMP();
        {
            pg8::Gemm g{(const bf16*)(a.ws + WS_U), (const bf16*)(a.ws + WS_WA_OUT) + (size_t)l * 1024 * 2048, M, D, AW}; pg8::StaticOrder S; S.init(M, D, G, (int)blockIdx.x);
            pg8::EpiY16 E{YOUT, D};
            pg8::gemm_phase<pg8::EpiY16, pg8::StaticOrder, true, true>(lds, g, S, E);
        }
        GRID_BAR();
        STAMP();
        { PHASE_IDS(); row_phase(YOUT, HN, a.a_post_g + l * D, RINV, nullptr, gw, NGW, lane); }
        GRID_BAR();
        STAMP();
    }
    { constexpr int l = 1;
        const bf16* Win = (const bf16*)(a.ws + WS_WA_IN) + (size_t)l * 6144 * 1024;
        {
            pg8::Gemm g{HN, Win, M, AW, D}; pg8::StaticOrder S; S.init(M, AW, G, (int)blockIdx.x);
            pg8::EpiUZ E{(bf16*)(a.ws + WS_U), (bf16*)(a.ws + WS_Z), RINV};
            pg8::gemm_phase<pg8::EpiUZ, pg8::StaticOrder, true, true>(lds, g, S, E);
        }
        STAMP();
        {
            pg8::Gemm g{Win + (size_t)4096 * 1024, HN, AW, M, D}; pg8::StaticOrder S; S.init(AW, M, G, (int)blockIdx.x);
            pg8::EpiT<true> E{(bf16*)(a.ws + WS_VT), (float*)(a.ws + WS_STAT), (float*)(a.ws + WS_STAT) + (size_t)16 * M, AW, RINV};
            pg8::gemm_phase<pg8::EpiT<true>, pg8::StaticOrder, true, true>(lds, g, S, E);
        }
        GRID_BAR();
        STAMP();
        {
            PHASE_IDS(); const float* ssum = (const float*)(a.ws + WS_STAT); const float* ssq = ssum + (size_t)16 * M;
            for (int tok = blockIdx.x * 512 + tid; tok < M; tok += G * 512) { float s = 0.f, q = 0.f;
#pragma unroll
                for (int k = 0; k < 16; ++k) { s += ssum[(size_t)k * M + tok]; q += ssq[(size_t)k * M + tok]; }
                const float mu = s * (1.f / AW); const float var = fmaxf(q * (1.f / AW) - mu * mu, 0.f);
                const float rstd = __builtin_amdgcn_rsqf(var + EPS); ((float*)(a.ws + WS_MU))[tok] = -mu * rstd; ((float*)(a.ws + WS_RSTD))[tok] = rstd; }
        }
        GRID_BAR();
        {
            pg8::GroupOrder S{(int)blockIdx.x, G};
            {
                PHASE_IDS(); const int g = ((int)blockIdx.x >> 3) & 7; const bf16* W16 = (const bf16*)(a.ws + WS_W16) + ((size_t)l * 8 + g) * 128 * 128;
                for (int c = tid; c < 20 * 64; c += 512) { const int f = c >> 6, r = (c >> 2) & 15, part = c & 3;
                    int m8 = 0, fb = 0;
#pragma unroll
                    for (int j = 1; j < 8; ++j) { const int b = ((j >> 1) + 1) * ((j >> 1) + (j & 1)); if (f >= b) { m8 = j; fb = b; } }
                    const int k = f - fb;
                    *(LAS v4u*)(lds + LDS_WL + f * 1280 + r * 80 + part * 16) = *(const v4u*)(W16 + (size_t)(16 * m8 + r) * 128 + 32 * k + 8 * part); }
                { pg8::Unit u0; S.next(0, u0); ((LAS float*)(lds + LDS_ST))[tid] = ((const float*)(a.ws + (tid < 256 ? WS_MU : WS_RSTD)))[(size_t)u0.pm * 256 + (tid & 255)]; }
                __syncthreads();
            }
            pg8::Gemm g{HN, Win + (size_t)2048 * 1024, M, AW, D};
            pg8::EpiZGate E{(bf16*)(a.ws + WS_U), (const bf16*)(a.ws + WS_VT), RINV, (const float*)(a.ws + WS_MU), (const float*)(a.ws + WS_RSTD),
                            a.a_ln_g + l * AW, a.a_ln_b + l * AW, a.a_b_s + l * 8 * 128, lds + LDS_WL, lds + LDS_ST, (int)(blockIdx.x >> 6), G >> 6};
            pg8::gemm_phase<pg8::EpiZGate, pg8::GroupOrder, true, true>(lds, g, S, E);
        }
        GRID_BAR();
        STAMP();
        {
            pg8::Gemm g{(const bf16*)(a.ws + WS_U), (const bf16*)(a.ws + WS_WA_OUT) + (size_t)l * 1024 * 2048, M, D, AW}; pg8::StaticOrder S; S.init(M, D, G, (int)blockIdx.x);
            pg8::EpiY16 E{YOUT, D};
            pg8::gemm_phase<pg8::EpiY16, pg8::StaticOrder, true, true>(lds, g, S, E);
        }
        GRID_BAR();
        STAMP();
        { PHASE_IDS(); row_phase(YOUT, HN, a.a_post_g + l * D, RINV, nullptr, gw, NGW, lane); }
        GRID_BAR();
        STAMP();
    }
    { constexpr int l = 0;
        const bf16* Win = (const bf16*)(a.ws + (l ? WS_WB_IN1 : WS_WB_IN0));
        bf16* Q = (bf16*)(a.ws + WS_U); bf16* ZG = Q + (size_t)M * D; bf16* KB = (bf16*)(a.ws + WS_Z); bf16* VTB = KB + (size_t)M * 256;
        {
            const int N = l ? 2048 : 2304;
            pg8::Gemm g{HN, Win, M, N, D}; pg8::StaticOrder S; S.init(M, N, G, (int)blockIdx.x);
            pg8::EpiBin E{a.ws, RINV};
            pg8::gemm_phase<pg8::EpiBin, pg8::StaticOrder, true, true>(lds, g, S, E);
        }
        STAMP();
        if (l == 0) {
            pg8::Gemm g{Win + (size_t)2304 * 1024, HN, 256, M, D}; pg8::StaticOrder S; S.init(256, M, G, (int)blockIdx.x);
            pg8::EpiT<false> E{VTB, nullptr, nullptr, 256, RINV};
            pg8::gemm_phase<pg8::EpiT<false>, pg8::StaticOrder, true, true>(lds, g, S, E);
        }
        GRID_BAR();
        STAMP();
        { PHASE_IDS(); attn_phase(a, l, lds, G, tid, wave, lane); }
        GRID_BAR();
        STAMP();
        {
            pg8::Gemm g{Q, (const bf16*)(a.ws + WS_WB_OUT) + (size_t)l * 1024 * 1024, M, D, D}; pg8::StaticOrder S; S.init(M, D, G, (int)blockIdx.x);
            pg8::EpiY16 E{YOUT, D};
            pg8::gemm_phase<pg8::EpiY16, pg8::StaticOrder, true, true>(lds, g, S, E);
        }
        GRID_BAR();
        STAMP();
        { PHASE_IDS(); row_phase(YOUT, HN, a.b_post_g + l * D, RINV, l == 0 ? nullptr : a.out, gw, NGW, lane); }
        if (l == 0) GRID_BAR();
        STAMP();
    }
    { constexpr int l = 1;
        const bf16* Win = (const bf16*)(a.ws + (l ? WS_WB_IN1 : WS_WB_IN0));
        bf16* Q = (bf16*)(a.ws + WS_U); bf16* ZG = Q + (size_t)M * D; bf16* KB = (bf16*)(a.ws + WS_Z); bf16* VTB = KB + (size_t)M * 256;
        {
            const int N = l ? 2048 : 2304;
            pg8::Gemm g{HN, Win, M, N, D}; pg8::StaticOrder S; S.init(M, N, G, (int)blockIdx.x);
            pg8::EpiBin E{a.ws, RINV};
            pg8::gemm_phase<pg8::EpiBin, pg8::StaticOrder, true, true>(lds, g, S, E);
        }
        STAMP();
        if (l == 0) {
            pg8::Gemm g{Win + (size_t)2304 * 1024, HN, 256, M, D}; pg8::StaticOrder S; S.init(256, M, G, (int)blockIdx.x);
            pg8::EpiT<false> E{VTB, nullptr, nullptr, 256, RINV};
            pg8::gemm_phase<pg8::EpiT<false>, pg8::StaticOrder, true, true>(lds, g, S, E);
        }
        GRID_BAR();
        STAMP();
        { PHASE_IDS(); attn_phase(a, l, lds, G, tid, wave, lane); }
        GRID_BAR();
        STAMP();
        {
            pg8::Gemm g{Q, (const bf16*)(a.ws + WS_WB_OUT) + (size_t)l * 1024 * 1024, M, D, D}; pg8::StaticOrder S; S.init(M, D, G, (int)blockIdx.x);
            pg8::EpiY16 E{YOUT, D};
            pg8::gemm_phase<pg8::EpiY16, pg8::StaticOrder, true, true>(lds, g, S, E);
        }
        GRID_BAR();
        STAMP();
        { PHASE_IDS(); row_phase(YOUT, HN, a.b_post_g + l * D, RINV, l == 0 ? nullptr : a.out, gw, NGW, lane); }
        if (l == 0) GRID_BAR();
        STAMP();
    }
#ifdef PROBE_A
    if (blockIdx.x == 0 && threadIdx.x < 64) {
        asm volatile("s_waitcnt vmcnt(0) lgkmcnt(0)" ::: "memory");
#ifdef PROBE_CONST
        int n = PROBE_CONST;
#else
        int n = (int)((tsl[PROBE_B] - tsl[PROBE_A]) / 100ull);
#endif
        n = n < 0 ? 0 : (n > 16384 ? 16384 : n);
#ifdef PROBE_BIG
        if (threadIdx.x == 0) a.out[0] = 1000.0f * (float)n;
        n = 0;
#endif
        for (int idx = threadIdx.x; idx < n; idx += 64) { float* p = a.out + ((size_t)(idx >> 12) * NGW * 4 + ((idx >> 10) & 3)) * D + (idx & 1023); *p = *p + 0.25f; }
    }
#endif
}

extern "C" void kernel_launch(void* const* d_in, const int* in_sizes, int n_in, void* d_out, int out_size, void* d_ws, size_t ws_size, hipStream_t stream) {
    static int grid = 0;
    if (grid == 0) {
        if (n_in != 17 || in_sizes[0] != M * D || out_size != M * D || ws_size < WS_END) { fprintf(stderr, "kernel_launch: unexpected shapes (n_in %d, in0 %d, out %d, ws %zu)\n", n_in, n_in > 0 ? in_sizes[0] : -1, out_size, ws_size); grid = -1; return; }
        int dev = 0, cus = 0, per_cu = 0;
        hipGetDevice(&dev); hipDeviceGetAttribute(&cus, hipDeviceAttributeMultiprocessorCount, dev);
        if (hipFuncSetAttribute((const void*)yoco_fwd, hipFuncAttributeMaxDynamicSharedMemorySize, LDS_BYTES) != hipSuccess) { fprintf(stderr, "kernel_launch: hipFuncSetAttribute failed\n"); grid = -1; return; }
        if (hipOccupancyMaxActiveBlocksPerMultiprocessor(&per_cu, (const void*)yoco_fwd, NWAVES * 64, LDS_BYTES) != hipSuccess || per_cu < 1) { fprintf(stderr, "kernel_launch: occupancy query says %d\n", per_cu); per_cu = 1; }
        (void)hipGetLastError();
        grid = cus;
        if (grid % 64 != 0) { fprintf(stderr, "kernel_launch: %d CUs; this kernel's unit orders need a multiple of 64\n", cus); grid = -1; return; }
    }
    if (grid < 0) return;
    Args a{};
    a.x = (const float*)d_in[0]; a.a_w_in = (const float*)d_in[1]; a.a_ln_g = (const float*)d_in[2]; a.a_ln_b = (const float*)d_in[3]; a.a_w_s = (const float*)d_in[4];
    a.a_b_s = (const float*)d_in[5]; a.a_w_out = (const float*)d_in[6]; a.a_pre_g = (const float*)d_in[7]; a.a_post_g = (const float*)d_in[8]; a.kv_norm_g = (const float*)d_in[9];
    a.w_k = (const float*)d_in[10]; a.w_v = (const float*)d_in[11]; a.b_w_in = (const float*)d_in[12]; a.b_sinks = (const float*)d_in[13]; a.b_w_out = (const float*)d_in[14];
    a.b_pre_g = (const float*)d_in[15]; a.b_post_g = (const float*)d_in[16];
    a.out = (float*)d_out; a.ws = (unsigned char*)d_ws;
    void* args[] = {&a};
    hipError_t e = hipLaunchCooperativeKernel((const void*)yoco_fwd, dim3(grid), dim3(NWAVES * 64), args, LDS_BYTES, stream);
    if (e != hipSuccess) fprintf(stderr, "kernel_launch: cooperative launch failed: %s (grid %d)\n", hipGetErrorString(e), grid);
}
```

```cpp
#include <hip/hip_runtime.h>
#include <hip/hip_cooperative_groups.h>
#include <cstdio>
#include <cstdint>
namespace cg = cooperative_groups;
namespace pg8 {
#define PG8_LAS __attribute__((address_space(3)))
typedef unsigned short bf16_t;
typedef short bf16x8 __attribute__((ext_vector_type(8)));
typedef float f32x4 __attribute__((ext_vector_type(4)));
typedef unsigned u32x4 __attribute__((ext_vector_type(4)));
constexpr int BM = 256, BK = 64, HALF = 128, HTB = HALF * BK * 2  , STAGE_BYTES = 8 * HTB, NXCD = 8, WGM = 8;

__host__ __device__ __forceinline__ int lds_byte(int r, int c) { const int st = (r >> 4) * 2 + (c >> 5), rr = r & 15, cc = c & 31, ob = rr * 64 + cc * 2; return st * 1024 + (ob ^ (((ob >> 9) & 1) << 5)); }
__host__ __device__ __forceinline__ void stage_rc(int b, int& R, int& C) { const int st = b / 1024, sb = b % 1024, swz = sb ^ (((sb >> 9) & 1) << 5); R = (st >> 1) * 16 + swz / 64; C = (st & 1) * 32 + (swz % 64) / 2; }
__host__ __device__ __forceinline__ int perm32(int rho) { const int n = rho >> 4, i = rho & 15; return 8 * (i >> 2) + 4 * n + (i & 3); }

struct Unit { int pm, pn; };
struct Gemm { const bf16_t* A; const bf16_t* Bt; int M, N, K; };

struct StaticOrder {
    int nM, nN, nwg, G, c;
    __host__ __device__ void init(int M, int N, int G_, int c_) { nM = M / BM; nN = N / BM; nwg = nM * nN; G = G_; c = c_; }
    __host__ __device__ bool next(int i, Unit& u) const {
        const long L = (long)i * G + c; if (L >= nwg) return false;
        int wgid = (int)L; { const int q = nwg / NXCD, r = nwg % NXCD, xcd = wgid % NXCD, off = wgid / NXCD; wgid = (xcd < r ? xcd * (q + 1) : r * (q + 1) + (xcd - r) * q) + off; }
        const int nig = WGM * nN, gid = wgid / nig, fm = gid * WGM, gsz = (nM - fm) < WGM ? (nM - fm) : WGM;
        u.pm = fm + ((wgid % nig) % gsz); u.pn = (wgid % nig) / gsz; return true;
    }
    __device__ __forceinline__ void a_ready(const Unit&) const {}
    __device__ __forceinline__ void done(const Unit&) const {}
};
__device__ __forceinline__ unsigned cvt_pk_bf16(float lo, float hi) { unsigned r; asm volatile("v_cvt_pk_bf16_f32 %0, %1, %2" : "=v"(r) : "v"(lo), "v"(hi)); return r; }
typedef float f32x2 __attribute__((ext_vector_type(2)));
template <class Epi, class Sched, bool ALIGN_EPI = false, bool SP2 = false>
__device__ __forceinline__ void gemm_phase(PG8_LAS unsigned char* lds, const Gemm g, const Sched& S, const Epi& E) {
    int tid_l = threadIdx.x; asm volatile("" : "+v"(tid_l));
    const int tid = tid_l, wid = __builtin_amdgcn_readfirstlane(tid >> 6), lane = tid & 63, wr = wid >> 2, wc = wid & 3, fr = lane & 15, fq = lane >> 4;
    const int K = g.K, nt = K / BK;
    unsigned voffA[2], voffB[2];
#pragma unroll
    for (int i = 0; i < 2; ++i) { int R, C; stage_rc(tid * 16 + i * 8192, R, C); const int Rb = Epi::PERM ? ((R & ~31) + perm32(R & 31)) : R;
        voffA[i] = (unsigned)(R * K + C) * 2u; voffB[i] = (unsigned)(Rb * K + C) * 2u; }
    const size_t kstep = (size_t)(BK * 2);
    const size_t hstep = (size_t)HALF * K * 2;
    const size_t tstep = 2 * hstep;
    const unsigned ldsw = (unsigned)wid * 1024u;
    const int aoff = lds_byte(wr * 64 + fr, fq * 8), boff = lds_byte(wc * 32 + fr, fq * 8);
#define PG8_SA(b, h) (((b) * 2 + (h)) * HTB)
#define PG8_SB(b, h) ((4 + (b) * 2 + (h)) * HTB)
#define PG8_STAGE(bufoff, gbase, voff) do { _Pragma("unroll") for (int _i = 0; _i < 2; ++_i) \
        __builtin_amdgcn_global_load_lds((const unsigned*)((const char*)(gbase) + (voff)[_i]), (PG8_LAS unsigned*)(lds + (bufoff) + ldsw + _i * 8192), 16, 0, 0); } while (0)
#define PG8_LDA(dst, b, h) do { _Pragma("unroll") for (int m = 0; m < 4; ++m) _Pragma("unroll") for (int k = 0; k < 2; ++k) dst[m][k] = *(const PG8_LAS bf16x8*)(lds + PG8_SA(b, h) + aoff + m * 2048 + k * 1024); } while (0)
#define PG8_LDB(dst, b, h) do { _Pragma("unroll") for (int n = 0; n < 2; ++n) _Pragma("unroll") for (int k = 0; k < 2; ++k) dst[n][k] = *(const PG8_LAS bf16x8*)(lds + PG8_SB(b, h) + boff + n * 2048 + k * 1024); } while (0)
#define PG8_MMA(ai, bj, At, Bt) do { __builtin_amdgcn_s_setprio(1); _Pragma("unroll") for (int m = 0; m < 4; ++m) _Pragma("unroll") for (int n = 0; n < 2; ++n) _Pragma("unroll") for (int k = 0; k < 2; ++k) \
        acc[ai][bj][m][n] = __builtin_amdgcn_mfma_f32_16x16x32_bf16(Bt[n][k], At[m][k], acc[ai][bj][m][n], 0, 0, 0); __builtin_amdgcn_s_setprio(0); } while (0)
#define PG8_WAIT_V(n) asm volatile("s_waitcnt vmcnt(" #n ")" ::: "memory")
#define PG8_WAIT_L(n) asm volatile("s_waitcnt lgkmcnt(" #n ")" ::: "memory")
#define PG8_BAR __builtin_amdgcn_s_barrier()
#define PG8_SCHED __builtin_amdgcn_sched_barrier(0)
    Unit cur, nxt; int ui = 0;
    if (!S.next(0, cur)) return;
    f32x4 acc[2][2][4][2];
#pragma unroll
    for (int a = 0; a < 2; ++a)
#pragma unroll
        for (int b = 0; b < 2; ++b)
#pragma unroll
            for (int m = 0; m < 4; ++m)
#pragma unroll
                for (int n = 0; n < 2; ++n) acc[a][b][m][n] = (f32x4){0.f, 0.f, 0.f, 0.f};
    bf16x8 At[4][2], B0[2][2], B1[2][2];
    const char* cA = (const char*)g.A + (size_t)cur.pm * tstep; const char* cB = (const char*)g.Bt + (size_t)cur.pn * tstep;
    S.a_ready(cur);
    if constexpr (SP2) {
        PG8_STAGE(PG8_SB(0, 0), cB, voffB); PG8_STAGE(PG8_SB(0, 1), cB + hstep, voffB); PG8_STAGE(PG8_SA(0, 0), cA, voffA); PG8_STAGE(PG8_SA(0, 1), cA + hstep, voffA);
        if (wr == 1) PG8_BAR;
        PG8_WAIT_V(2); PG8_BAR;
        PG8_STAGE(PG8_SB(1, 0), cB + kstep, voffB); PG8_STAGE(PG8_SA(1, 0), cA + kstep, voffA); PG8_STAGE(PG8_SB(1, 1), cB + hstep + kstep, voffB);
        PG8_WAIT_V(6); PG8_BAR;
    } else {
        PG8_STAGE(PG8_SB(0, 0), cB, voffB); PG8_STAGE(PG8_SA(0, 0), cA, voffA); PG8_STAGE(PG8_SB(0, 1), cB + hstep, voffB); PG8_STAGE(PG8_SA(0, 1), cA + hstep, voffA);
        if (wr == 1) PG8_BAR;
        PG8_WAIT_V(4); PG8_BAR;
        PG8_STAGE(PG8_SB(1, 0), cB + kstep, voffB); PG8_STAGE(PG8_SA(1, 0), cA + kstep, voffA); PG8_STAGE(PG8_SB(1, 1), cB + hstep + kstep, voffB);
        PG8_WAIT_V(6); PG8_BAR;
    }
    for (;;) {
        const bool has_next = S.next(ui + 1, nxt);
        const char* nA = has_next ? (const char*)g.A + (size_t)nxt.pm * tstep : cA; const char* nB = has_next ? (const char*)g.Bt + (size_t)nxt.pn * tstep : cB;
        for (int t = 0; t < nt; t += 2) {
            const bool last = (t == nt - 2);
            const char* a1 = cA + (size_t)(t + 1) * kstep;
            const char* a2 = last ? nA : cA + (size_t)(t + 2) * kstep; const char* b2 = last ? nB : cB + (size_t)(t + 2) * kstep;
            const char* a3 = a2 + kstep; const char* b3 = b2 + kstep;
            if (last && has_next) S.a_ready(nxt);
            if constexpr (SP2) {
            PG8_LDB(B0, 0, 0); PG8_LDB(B1, 0, 1); PG8_SCHED; PG8_LDA(At, 0, 0); PG8_STAGE(PG8_SA(1, 1), a1 + hstep, voffA);
            PG8_WAIT_V(8); PG8_WAIT_L(0); PG8_BAR; PG8_MMA(0, 0, At, B0); PG8_MMA(0, 1, At, B1); PG8_BAR; PG8_SCHED;
            PG8_LDA(At, 0, 1); PG8_STAGE(PG8_SB(0, 0), b2, voffB); PG8_STAGE(PG8_SB(0, 1), b2 + hstep, voffB); PG8_STAGE(PG8_SA(0, 0), a2, voffA);
            PG8_WAIT_V(8); PG8_WAIT_L(0); PG8_BAR; PG8_MMA(1, 0, At, B0); PG8_MMA(1, 1, At, B1); PG8_BAR; PG8_SCHED;
            PG8_LDB(B0, 1, 0); PG8_LDB(B1, 1, 1); PG8_SCHED; PG8_LDA(At, 1, 0); PG8_STAGE(PG8_SA(0, 1), a2 + hstep, voffA);
            PG8_WAIT_V(8); PG8_WAIT_L(0); PG8_BAR; PG8_MMA(0, 0, At, B0); PG8_MMA(0, 1, At, B1); PG8_BAR; PG8_SCHED;
            PG8_LDA(At, 1, 1); PG8_STAGE(PG8_SB(1, 0), b3, voffB); PG8_STAGE(PG8_SB(1, 1), b3 + hstep, voffB); PG8_STAGE(PG8_SA(1, 0), a3, voffA);
            PG8_WAIT_V(8); PG8_WAIT_L(0); PG8_BAR; PG8_MMA(1, 0, At, B0); PG8_MMA(1, 1, At, B1); PG8_BAR; PG8_SCHED;
            } else {
            PG8_LDB(B0, 0, 0); PG8_SCHED; PG8_LDA(At, 0, 0); PG8_STAGE(PG8_SA(1, 1), a1 + hstep, voffA);
            PG8_WAIT_L(8); PG8_BAR; PG8_WAIT_L(0); PG8_MMA(0, 0, At, B0); PG8_BAR; PG8_SCHED;
            PG8_LDB(B1, 0, 1); PG8_STAGE(PG8_SB(0, 0), b2, voffB);
            PG8_BAR; PG8_WAIT_L(0); PG8_MMA(0, 1, At, B1); PG8_BAR;
            PG8_LDA(At, 0, 1); PG8_STAGE(PG8_SA(0, 0), a2, voffA);
            PG8_BAR; PG8_WAIT_L(0); PG8_MMA(1, 0, At, B0); PG8_BAR; PG8_SCHED;
            PG8_STAGE(PG8_SB(0, 1), b2 + hstep, voffB);
            PG8_WAIT_V(6); PG8_BAR; PG8_MMA(1, 1, At, B1); PG8_BAR;
            PG8_LDB(B0, 1, 0); PG8_SCHED; PG8_LDA(At, 1, 0); PG8_STAGE(PG8_SA(0, 1), a2 + hstep, voffA);
            PG8_WAIT_L(8); PG8_BAR; PG8_WAIT_L(0); PG8_MMA(0, 0, At, B0); PG8_BAR; PG8_SCHED;
            PG8_LDB(B1, 1, 1); PG8_STAGE(PG8_SB(1, 0), b3, voffB);
            PG8_BAR; PG8_WAIT_L(0); PG8_MMA(0, 1, At, B1); PG8_BAR;
            PG8_LDA(At, 1, 1); PG8_STAGE(PG8_SA(1, 0), a3, voffA);
            PG8_BAR; PG8_WAIT_L(0); PG8_MMA(1, 0, At, B0); PG8_BAR; PG8_SCHED;
            PG8_STAGE(PG8_SB(1, 1), b3 + hstep, voffB);
            PG8_WAIT_V(6); PG8_BAR; PG8_MMA(1, 1, At, B1); PG8_BAR;
            }
        }
        if constexpr (ALIGN_EPI) { if (wr == 0) PG8_BAR; }
        if constexpr (!Epi::AFTER_DRAIN) { E(acc, cur, wr, wc, fr, fq); S.done(cur); }
        if (!has_next) break;
#pragma unroll
        for (int a = 0; a < 2; ++a)
#pragma unroll
            for (int b = 0; b < 2; ++b)
#pragma unroll
                for (int m = 0; m < 4; ++m)
#pragma unroll
                    for (int n = 0; n < 2; ++n) acc[a][b][m][n] = (f32x4){0.f, 0.f, 0.f, 0.f};
        cur = nxt; cA = nA; cB = nB; ++ui;
        if constexpr (ALIGN_EPI) { if (wr == 1) PG8_BAR; }
    }
    PG8_WAIT_V(0);
    if constexpr (!ALIGN_EPI) { if (wr == 0) PG8_BAR; }
    PG8_BAR;
    if constexpr (Epi::AFTER_DRAIN) { E.fused(acc, cur, wr, wc, fr, fq, lds, wid, lane); S.done(cur); }
#undef PG8_SA
#undef PG8_SB
#undef PG8_STAGE
#undef PG8_LDA
#undef PG8_LDB
#undef PG8_MMA
#undef PG8_WAIT_V
#undef PG8_WAIT_L
#undef PG8_BAR
#undef PG8_SCHED
}
}


constexpr int NWAVES = 8;
constexpr int M = 65536, D = 1024, AW = 2048, SEQ = 4096, CH = 128;
constexpr float EPS = 1e-6f;
constexpr size_t MiB = 1u << 20;
constexpr size_t WS_WA_IN = 1 * MiB;
constexpr size_t WS_WA_OUT = 25 * MiB;
constexpr size_t WS_WB_IN0 = 33 * MiB;
constexpr size_t WS_WB_IN1 = 38 * MiB;
constexpr size_t WS_WB_OUT = 42 * MiB;
constexpr size_t WS_STAT = 46 * MiB;
constexpr size_t WS_RINV = 54 * MiB;
constexpr size_t WS_W16 = 55 * MiB;
constexpr size_t WS_MU = 56 * MiB;
constexpr size_t WS_RSTD = 57 * MiB;
constexpr size_t WS_HN = 64 * MiB;
constexpr size_t WS_U = 192 * MiB;
constexpr size_t WS_VT = 448 * MiB;
constexpr size_t WS_Z = 704 * MiB;
constexpr size_t WS_END = 960 * MiB;
constexpr int LDS_WL = 131072, LDS_WL_BYTES = 20 * 1280;
constexpr int LDS_MISC = LDS_WL + LDS_WL_BYTES;
constexpr int LDS_ST = LDS_MISC + 512;
constexpr int LDS_BYTES = LDS_ST + 4096;

#define LAS __attribute__((address_space(3)))
typedef unsigned short bf16;
typedef unsigned v4u __attribute__((ext_vector_type(4)));
typedef unsigned v2u __attribute__((ext_vector_type(2)));
typedef float f32x4 __attribute__((ext_vector_type(4)));
typedef short bf16x8 __attribute__((ext_vector_type(8)));
typedef short bf16x4 __attribute__((ext_vector_type(4)));

__device__ __forceinline__ unsigned f2bf(float f) { unsigned u = __builtin_bit_cast(unsigned, f); return (u + 0x7fffu + ((u >> 16) & 1u)) >> 16; }
__device__ __forceinline__ unsigned pk2(float lo, float hi) { return pg8::cvt_pk_bf16(lo, hi); }
__device__ __forceinline__ float bflo(unsigned w) { return __builtin_bit_cast(float, w << 16); }
__device__ __forceinline__ float bfhi(unsigned w) { return __builtin_bit_cast(float, w & 0xffff0000u); }
__device__ __forceinline__ float wave_sum(float v) {
#pragma unroll
    for (int o = 1; o < 64; o <<= 1) v += __shfl_xor(v, o);
    return v;
}
__device__ __forceinline__ float act_sig(float x, float c1n, float c3n) {
    const float t = x * (c1n + c3n * x * x);
    return x * __builtin_amdgcn_rcpf(1.0f + __builtin_amdgcn_exp2f(t));
}
__device__ __forceinline__ float row16_sum(float v) {
    v += __builtin_bit_cast(float, __builtin_amdgcn_update_dpp(0, __builtin_bit_cast(int, v), 0xB1, 0xF, 0xF, false));
    v += __builtin_bit_cast(float, __builtin_amdgcn_update_dpp(0, __builtin_bit_cast(int, v), 0x4E, 0xF, 0xF, false));
    v += __builtin_bit_cast(float, __builtin_amdgcn_update_dpp(0, __builtin_bit_cast(int, v), 0x141, 0xF, 0xF, false));
    v += __builtin_bit_cast(float, __builtin_amdgcn_update_dpp(0, __builtin_bit_cast(int, v), 0x140, 0xF, 0xF, false));
    return v;
}
__device__ __forceinline__ float silu_f(float x) { return x * __builtin_amdgcn_rcpf(1.0f + __builtin_amdgcn_exp2f(x * -1.4426950408889634f)); }
constexpr float LOG2E = 1.4426950408889634f;
constexpr float GELU_C1N = -1.5957691216057308f * LOG2E, GELU_C3N = -0.07135481627f * LOG2E, SILU_C1N = -LOG2E;

namespace pg8 {
struct EpiUZ {
    static constexpr bool PERM = true, AFTER_DRAIN = false;
    bf16_t* U; bf16_t* Z; const float* rinv;
    __device__ __forceinline__ void operator()(const f32x4 (&acc)[2][2][4][2], const Unit& u, int wr, int wc, int fr, int fq) const {
        const bool isz = u.pn >= 8; bf16_t* base = isz ? Z : U;
        const float c1 = isz ? SILU_C1N : GELU_C1N, c3 = isz ? 0.f : GELU_C3N;
        const int row0 = u.pm * BM + wr * 64 + fr, col0 = (u.pn & 7) * BM + wc * 32 + 8 * fq;
#pragma unroll
        for (int ai = 0; ai < 2; ++ai)
#pragma unroll
            for (int m = 0; m < 4; ++m) { bf16_t* rowp = base + (size_t)(row0 + ai * HALF + m * 16) * AW + col0; const float rs = rinv[row0 + ai * HALF + m * 16];
#pragma unroll
                for (int bj = 0; bj < 2; ++bj) { const f32x4 v0 = acc[ai][bj][m][0] * rs, v1 = acc[ai][bj][m][1] * rs; u32x4 w;
                    w.x = cvt_pk_bf16(act_sig(v0[0], c1, c3), act_sig(v0[1], c1, c3)); w.y = cvt_pk_bf16(act_sig(v0[2], c1, c3), act_sig(v0[3], c1, c3));
                    w.z = cvt_pk_bf16(act_sig(v1[0], c1, c3), act_sig(v1[1], c1, c3)); w.w = cvt_pk_bf16(act_sig(v1[2], c1, c3), act_sig(v1[3], c1, c3));
                    __builtin_nontemporal_store(w, (u32x4*)(rowp + bj * HALF)); } }
    }
};
template <bool GELU> struct EpiT {
    static constexpr bool PERM = true, AFTER_DRAIN = false;
    bf16_t* OT; float* ssum; float* ssq; int nch; const float* rinv;
    __device__ __forceinline__ void operator()(const f32x4 (&acc)[2][2][4][2], const Unit& u, int wr, int wc, int fr, int fq) const {
        const int row0 = u.pm * BM + wr * 64 + fr, col0 = u.pn * BM + wc * 32 + 8 * fq;
        f32x4 s[2][2], q[2][2], rs[2][2];
#pragma unroll
        for (int bj = 0; bj < 2; ++bj)
#pragma unroll
            for (int n = 0; n < 2; ++n) { s[bj][n] = (f32x4){0.f, 0.f, 0.f, 0.f}; q[bj][n] = (f32x4){0.f, 0.f, 0.f, 0.f}; rs[bj][n] = *(const f32x4*)(rinv + col0 + bj * HALF + 4 * n); }
#pragma unroll
        for (int ai = 0; ai < 2; ++ai)
#pragma unroll
            for (int m = 0; m < 4; ++m) { bf16_t* rowp = OT + ((size_t)(u.pn * 2) * nch + (row0 + ai * HALF + m * 16)) * 128 + wc * 32 + 8 * fq;
#pragma unroll
                for (int bj = 0; bj < 2; ++bj) { f32x4 v0 = acc[ai][bj][m][0] * rs[bj][0], v1 = acc[ai][bj][m][1] * rs[bj][1];
                    if (GELU) {
#pragma unroll
                        for (int j = 0; j < 4; ++j) { v0[j] = act_sig(v0[j], GELU_C1N, GELU_C3N); v1[j] = act_sig(v1[j], GELU_C1N, GELU_C3N); }
                        s[bj][0] += v0; s[bj][1] += v1; q[bj][0] += v0 * v0; q[bj][1] += v1 * v1; }
                    u32x4 w; w.x = cvt_pk_bf16(v0[0], v0[1]); w.y = cvt_pk_bf16(v0[2], v0[3]); w.z = cvt_pk_bf16(v1[0], v1[1]); w.w = cvt_pk_bf16(v1[2], v1[3]);
                    __builtin_nontemporal_store(w, (u32x4*)(rowp + (size_t)bj * nch * 128)); } }
        if (GELU) {
#pragma unroll
            for (int bj = 0; bj < 2; ++bj)
#pragma unroll
                for (int n = 0; n < 2; ++n)
#pragma unroll
                    for (int j = 0; j < 4; ++j) { s[bj][n][j] = row16_sum(s[bj][n][j]); q[bj][n][j] = row16_sum(q[bj][n][j]); }
            if (fr == 0) { const size_t slot = (size_t)(u.pm * 2 + wr) * M + col0;
#pragma unroll
                for (int bj = 0; bj < 2; ++bj)
#pragma unroll
                    for (int n = 0; n < 2; ++n) { *(f32x4*)(ssum + slot + bj * HALF + 4 * n) = s[bj][n]; *(f32x4*)(ssq + slot + bj * HALF + 4 * n) = q[bj][n]; } }
        }
    }
};
struct EpiBin {
    static constexpr bool PERM = true, AFTER_DRAIN = false;
    unsigned char* ws; const float* rinv;
    __device__ __forceinline__ void operator()(const f32x4 (&acc)[2][2][4][2], const Unit& u, int wr, int wc, int fr, int fq) const {
        const bool isz = (u.pn >= 4) && (u.pn < 8); const bool isk = u.pn >= 8;
        const size_t boff = isk ? (size_t)(WS_Z) : (isz ? (size_t)(WS_U + (size_t)M * D * 2) : (size_t)WS_U);
        bf16_t* base = (bf16_t*)(ws + boff); const int ldc = isk ? 256 : 1024;
        const int row0 = u.pm * BM + wr * 64 + fr, col0 = (isk ? 0 : (u.pn & 3) * BM) + wc * 32 + 8 * fq;
#pragma unroll
        for (int ai = 0; ai < 2; ++ai)
#pragma unroll
            for (int m = 0; m < 4; ++m) { bf16_t* rowp = base + (size_t)(row0 + ai * HALF + m * 16) * ldc + col0; const float rs = rinv[row0 + ai * HALF + m * 16];
#pragma unroll
                for (int bj = 0; bj < 2; ++bj) { f32x4 v0 = acc[ai][bj][m][0] * rs, v1 = acc[ai][bj][m][1] * rs;
                    if (isz) { v0 = (f32x4){silu_f(v0.x), silu_f(v0.y), silu_f(v0.z), silu_f(v0.w)};
                        v1 = (f32x4){silu_f(v1.x), silu_f(v1.y), silu_f(v1.z), silu_f(v1.w)}; }
                    u32x4 w; w.x = cvt_pk_bf16(v0[0], v0[1]); w.y = cvt_pk_bf16(v0[2], v0[3]); w.z = cvt_pk_bf16(v1[0], v1[1]); w.w = cvt_pk_bf16(v1[2], v1[3]);
                    __builtin_nontemporal_store(w, (u32x4*)(rowp + bj * HALF)); } }
    }
};
struct GroupOrder {
    int c, G;
    __device__ __forceinline__ bool next(int i, Unit& u) const { const int J8 = G >> 6, j = c >> 3, off = (j >> 3) + J8 * i; if (off >= 32) return false; u.pn = j & 7; u.pm = 32 * (c & 7) + off; return true; }
    __device__ __forceinline__ void a_ready(const Unit&) const {}
    __device__ __forceinline__ void done(const Unit&) const {}
};
struct EpiZGate {
    static constexpr bool PERM = true, AFTER_DRAIN = false;
    bf16_t* U; const bf16_t* VT; const float* rinv; const float* mu; const float* rstd;
    const float* lng; const float* lnb; const float* bsv; PG8_LAS unsigned char* wl; PG8_LAS unsigned char* st; int off0, J8;
    __device__ __forceinline__ void load_raw(u32x4 (&raw)[2][4], int chunk, int cb, int wr, int fr, int fq) const {
#pragma unroll
        for (int n = 0; n < 2; ++n) { const int ch = cb + 8 * (fr >> 2) + 4 * n + (fr & 3); const bf16_t* vp = VT + ((size_t)chunk * 2048 + ch) * 128 + 8 * fq;
#pragma unroll
            for (int k = 0; k < 4; ++k) { if (k <= 2 * wr + 1) raw[n][k] = *(const u32x4*)(vp + 32 * k); } }
    }
    __device__ __forceinline__ void operator()(const f32x4 (&acc)[2][2][4][2], const Unit& u, int wr, int wc, int fr_in, int fq_in) const {
        const int g = u.pn;
        const int uidx = ((u.pm & 31) - off0) / J8; const PG8_LAS unsigned char* stc = st + (uidx & 1) * 2048; PG8_LAS unsigned char* stn = st + ((uidx + 1) & 1) * 2048;
        asm volatile("s_waitcnt lgkmcnt(0)" ::: "memory"); __builtin_amdgcn_s_barrier(); asm volatile("" ::: "memory");
        float stnext;
        { const int tid = (wr * 4 + wc) * 64 + fq_in * 16 + fr_in; int pmn = u.pm + J8; if ((pmn & 31) < (u.pm & 31)) pmn = u.pm;
          stnext = (tid < 256 ? mu : rstd)[(size_t)pmn * 256 + (tid & 255)]; }
        u32x4 raw[2][4], zs[3][4], un[4]; float rs0[4], bs[4], lgn[2], lbn[2];
        {
            int fr = fr_in, fq = fq_in; asm volatile("" : "+v"(fr), "+v"(fq));
            float rs1[4];
#pragma unroll
            for (int m = 0; m < 4; ++m) { const int t = 64 * wr + 16 * m + fr; rs1[m] = rinv[(size_t)(2 * u.pm + 1) * 128 + t]; rs0[m] = rinv[(size_t)(2 * u.pm) * 128 + t]; bs[m] = bsv[g * 128 + t]; }
#pragma unroll
            for (int n = 0; n < 2; ++n) { const int ch = g * 256 + 32 * wc + 8 * (fr >> 2) + 4 * n + (fr & 3); lgn[n] = lng[ch]; lbn[n] = lnb[ch]; }
            asm volatile("" ::: "memory");
            load_raw(raw, 2 * u.pm, g * 256 + 32 * wc, wr, fr, fq);
#pragma unroll
            for (int m = 0; m < 4; ++m) un[m] = *(const u32x4*)(U + ((size_t)(2 * u.pm) * 128 + 64 * wr + 16 * m + fr) * AW + g * 256 + 32 * wc + 8 * fq);
            asm volatile("" ::: "memory");
#pragma unroll
            for (int blk = 1; blk < 4; ++blk)
#pragma unroll
                for (int m = 0; m < 4; ++m) { const float r_ = (blk >> 1) ? rs1[m] : rs0[m]; const f32x4 z0 = acc[blk >> 1][blk & 1][m][0] * r_, z1 = acc[blk >> 1][blk & 1][m][1] * r_;
                    zs[blk - 1][m].x = cvt_pk_bf16(silu_f(z0.x), silu_f(z0.y)); zs[blk - 1][m].y = cvt_pk_bf16(silu_f(z0.z), silu_f(z0.w));
                    zs[blk - 1][m].z = cvt_pk_bf16(silu_f(z1.x), silu_f(z1.y)); zs[blk - 1][m].w = cvt_pk_bf16(silu_f(z1.z), silu_f(z1.w)); }
        }
#pragma unroll
        for (int blk = 0; blk < 4; ++blk) {
            const int ai = blk >> 1, bj = blk & 1;
            const int chunk = 2 * u.pm + ai; const size_t tok0 = (size_t)chunk * 128;
            const int cb = g * 256 + 128 * bj + 32 * wc;
            int fr = fr_in, fq = fq_in; asm volatile("" : "+v"(fr), "+v"(fq));
            u32x4 uu[4], vf[2][4]; float lg[2], lb[2];
#pragma unroll
            for (int m = 0; m < 4; ++m) uu[m] = un[m];
#pragma unroll
            for (int n = 0; n < 2; ++n) { lg[n] = lgn[n]; lb[n] = lbn[n]; }
#pragma unroll
            for (int k = 0; k < 4; ++k) { if (k <= 2 * wr + 1) { const int s = 32 * k + 8 * fq;
                const PG8_LAS float* sp = (const PG8_LAS float*)stc + ai * 128 + s;
                const f32x4 m0 = *(const PG8_LAS f32x4*)sp, m1 = *(const PG8_LAS f32x4*)(sp + 4), r0 = *(const PG8_LAS f32x4*)(sp + 256), r1 = *(const PG8_LAS f32x4*)(sp + 260);
#pragma unroll
                for (int n = 0; n < 2; ++n) { const u32x4 rw = raw[n][k]; const float g_ = lg[n], b_ = lb[n]; u32x4 o;
                    o.x = cvt_pk_bf16((bflo(rw.x) * r0.x + m0.x) * g_ + b_, (bfhi(rw.x) * r0.y + m0.y) * g_ + b_);
                    o.y = cvt_pk_bf16((bflo(rw.y) * r0.z + m0.z) * g_ + b_, (bfhi(rw.y) * r0.w + m0.w) * g_ + b_);
                    o.z = cvt_pk_bf16((bflo(rw.z) * r1.x + m1.x) * g_ + b_, (bfhi(rw.z) * r1.y + m1.y) * g_ + b_);
                    o.w = cvt_pk_bf16((bflo(rw.w) * r1.z + m1.z) * g_ + b_, (bfhi(rw.w) * r1.w + m1.w) * g_ + b_);
                    vf[n][k] = o; } } }
            asm volatile("" ::: "memory");
            if (blk < 3) { const int nb = blk + 1; load_raw(raw, 2 * u.pm + (nb >> 1), g * 256 + 128 * (nb & 1) + 32 * wc, wr, fr, fq);
#pragma unroll
                for (int m = 0; m < 4; ++m) un[m] = *(const u32x4*)(U + ((size_t)(2 * u.pm + (nb >> 1)) * 128 + 64 * wr + 16 * m + fr) * AW + g * 256 + 128 * (nb & 1) + 32 * wc + 8 * fq);
#pragma unroll
                for (int n = 0; n < 2; ++n) { const int ch = g * 256 + 128 * (nb & 1) + 32 * wc + 8 * (fr >> 2) + 4 * n + (fr & 3); lgn[n] = lng[ch]; lbn[n] = lnb[ch]; } }
            asm volatile("" ::: "memory");
#pragma unroll
            for (int m = 0; m < 4; ++m) {
                const int m8 = 4 * wr + m, p = m8 >> 1, kmax = p, fbase = (p + 1) * (p + (m8 & 1));
                const PG8_LAS unsigned char* wp = wl + fbase * 1280 + fr * 80 + fq * 16;
                f32x4 s0 = (f32x4){0.f, 0.f, 0.f, 0.f}, s1 = (f32x4){0.f, 0.f, 0.f, 0.f};
#pragma unroll
                for (int k = 0; k < 4; ++k) { if (k <= kmax) { const bf16x8 wf = *(const PG8_LAS bf16x8*)(wp + k * 1280);
                    s0 = __builtin_amdgcn_mfma_f32_16x16x32_bf16(__builtin_bit_cast(bf16x8, vf[0][k]), wf, s0, 0, 0, 0);
                    s1 = __builtin_amdgcn_mfma_f32_16x16x32_bf16(__builtin_bit_cast(bf16x8, vf[1][k]), wf, s1, 0, 0, 0); } }
                const float b_ = bs[m]; const u32x4 ux = uu[m];
                f32x4 g0, g1;
                if (blk == 0) { const f32x4 z0 = acc[0][0][m][0] * rs0[m], z1 = acc[0][0][m][1] * rs0[m];
                    g0 = (f32x4){silu_f(z0.x), silu_f(z0.y), silu_f(z0.z), silu_f(z0.w)}; g1 = (f32x4){silu_f(z1.x), silu_f(z1.y), silu_f(z1.z), silu_f(z1.w)}; }
                else { const u32x4 zz = zs[blk - 1][m]; g0 = (f32x4){bflo(zz.x), bfhi(zz.x), bflo(zz.y), bfhi(zz.y)}; g1 = (f32x4){bflo(zz.z), bfhi(zz.z), bflo(zz.w), bfhi(zz.w)}; }
                u32x4 o;
                o.x = cvt_pk_bf16(bflo(ux.x) * (s0.x + b_) * g0.x, bfhi(ux.x) * (s0.y + b_) * g0.y);
                o.y = cvt_pk_bf16(bflo(ux.y) * (s0.z + b_) * g0.z, bfhi(ux.y) * (s0.w + b_) * g0.w);
                o.z = cvt_pk_bf16(bflo(ux.z) * (s1.x + b_) * g1.x, bfhi(ux.z) * (s1.y + b_) * g1.y);
                o.w = cvt_pk_bf16(bflo(ux.w) * (s1.z + b_) * g1.z, bfhi(ux.w) * (s1.w + b_) * g1.w);
                *(u32x4*)(U + (tok0 + 64 * wr + 16 * m + fr) * AW + cb + 8 * fq) = o;
            }
        }
        { const int tid = (wr * 4 + wc) * 64 + fq_in * 16 + fr_in; ((PG8_LAS float*)stn)[tid] = stnext; }
    }
};
struct EpiY16 {
    static constexpr bool PERM = true, AFTER_DRAIN = false;
    bf16_t* C; int ldc;
    __device__ __forceinline__ void operator()(const f32x4 (&acc)[2][2][4][2], const Unit& u, int wr, int wc, int fr, int fq) const {
        const int row0 = u.pm * BM + wr * 64 + fr, col0 = u.pn * BM + wc * 32 + 8 * fq;
#pragma unroll
        for (int ai = 0; ai < 2; ++ai)
#pragma unroll
            for (int m = 0; m < 4; ++m) { bf16_t* rowp = C + (size_t)(row0 + ai * HALF + m * 16) * ldc + col0;
#pragma unroll
                for (int bj = 0; bj < 2; ++bj) { const f32x4 v0 = acc[ai][bj][m][0], v1 = acc[ai][bj][m][1];
                    u32x4 w; w.x = cvt_pk_bf16(v0[0], v0[1]); w.y = cvt_pk_bf16(v0[2], v0[3]); w.z = cvt_pk_bf16(v1[0], v1[1]); w.w = cvt_pk_bf16(v1[2], v1[3]);
                    __builtin_nontemporal_store(w, (u32x4*)(rowp + bj * HALF)); } }
    }
};
}

struct Args {
    const float* x; const float* a_w_in; const float* a_ln_g; const float* a_ln_b; const float* a_w_s; const float* a_b_s; const float* a_w_out;
    const float* a_pre_g; const float* a_post_g; const float* kv_norm_g; const float* w_k; const float* w_v; const float* b_w_in; const float* b_sinks;
    const float* b_w_out; const float* b_pre_g; const float* b_post_g;
    float* out; unsigned char* ws;
};

__device__ __forceinline__ void transpose_item(const float* W, int ldw, int col0, int K, bf16* WT, int row_off, int nblk, const float* gv, float mult, LAS float* scr, int item, int lane) {
    const int kb = item / nblk, nb = item % nblk, k0 = 64 * kb, n0 = 32 * nb;
    float wv[32], gg[32];
#pragma unroll
    for (int i = 0; i < 32; ++i) { const int kk = 2 * i + (lane >> 5); wv[i] = W[(size_t)(k0 + kk) * ldw + col0 + n0 + (lane & 31)]; gg[i] = gv ? gv[k0 + kk] : 1.0f; }
#pragma unroll
    for (int i = 0; i < 32; ++i) { const int kk = 2 * i + (lane >> 5); scr[kk * 33 + (lane & 31)] = wv[i] * (gg[i] * mult); }
    asm volatile("s_waitcnt lgkmcnt(0)" ::: "memory");
    const int c = lane & 7;
#pragma unroll
    for (int j = 0; j < 4; ++j) { const int n = (lane >> 3) + 8 * j; const LAS float* s = scr + (8 * c) * 33 + n;
        v4u o; o.x = pk2(s[0 * 33], s[1 * 33]); o.y = pk2(s[2 * 33], s[3 * 33]); o.z = pk2(s[4 * 33], s[5 * 33]); o.w = pk2(s[6 * 33], s[7 * 33]);
        *(v4u*)(WT + (size_t)(row_off + n0 + n) * K + k0 + 8 * c) = o; }
    asm volatile("s_waitcnt lgkmcnt(0)" ::: "memory");
}

__device__ __forceinline__ void p0_prologue(const Args& a, LAS unsigned char* lds, int gw, int NGW, int wave, int lane) {
    LAS float* scr = (LAS float*)(lds + wave * 16384);
    bf16* ws_wa_in = (bf16*)(a.ws + WS_WA_IN); bf16* ws_wa_out = (bf16*)(a.ws + WS_WA_OUT);
    bf16* ws_wb_in0 = (bf16*)(a.ws + WS_WB_IN0); bf16* ws_wb_in1 = (bf16*)(a.ws + WS_WB_IN1); bf16* ws_wb_out = (bf16*)(a.ws + WS_WB_OUT);
    constexpr int I_AIN = 16 * 64;
    constexpr int I_AOUT = 32 * 32;
    constexpr int I_BIN = 16 * 32;
    constexpr int I_KV = 16 * 8;
    constexpr int I_BOUT = 16 * 32;
    constexpr int NITEMS = 6 * I_AIN + 2 * I_AOUT + 4 * I_BIN + 2 * I_KV + 2 * I_BOUT;
    for (int it = gw; it < NITEMS; it += NGW) {
        int r = it;
        if (r < 6 * I_AIN) { const int l = r / (3 * I_AIN), part = (r / I_AIN) % 3, item = r % I_AIN;
            const int col0 = part == 0 ? 0 : (part == 1 ? 4096 : 2048);
            transpose_item(a.a_w_in + (size_t)l * 1024 * 6144, 6144, col0, 1024, ws_wa_in + (size_t)l * 6144 * 1024, part * 2048, 64, a.a_pre_g + l * 1024, 1.0f, scr, item, lane); continue; }
        r -= 6 * I_AIN;
        if (r < 2 * I_AOUT) { const int l = r / I_AOUT, item = r % I_AOUT;
            transpose_item(a.a_w_out + (size_t)l * 2048 * 1024, 1024, 0, 2048, ws_wa_out + (size_t)l * 1024 * 2048, 0, 32, nullptr, 1.0f, scr, item, lane); continue; }
        r -= 2 * I_AOUT;
        if (r < 4 * I_BIN) { const int l = r / (2 * I_BIN), part = (r / I_BIN) & 1, item = r % I_BIN;
            transpose_item(a.b_w_in + (size_t)l * 1024 * 2048, 2048, part * 1024, 1024, l ? ws_wb_in1 : ws_wb_in0, part * 1024, 32, a.b_pre_g + l * 1024, part == 0 ? 0.125f : 1.0f, scr, item, lane); continue; }
        r -= 4 * I_BIN;
        if (r < 2 * I_KV) { const int part = r / I_KV, item = r % I_KV;
            transpose_item(part ? a.w_v : a.w_k, 256, 0, 1024, ws_wb_in0, 2048 + part * 256, 8, a.kv_norm_g, 1.0f, scr, item, lane); continue; }
        r -= 2 * I_KV;
        { const int l = r / I_BOUT, item = r % I_BOUT;
            transpose_item(a.b_w_out + (size_t)l * 1024 * 1024, 1024, 0, 1024, ws_wb_out + (size_t)l * 1024 * 1024, 0, 32, nullptr, 1.0f, scr, item, lane); }
    }
    { bf16* W16 = (bf16*)(a.ws + WS_W16); const int gt = gw * 64 + lane, NT = NGW * 64;
      for (int i = gt; i < 2 * 8 * 128 * 16; i += NT) { const int t = (i >> 4) & 127, s = (i & 15) * 8; const float* src = a.a_w_s + (size_t)i * 8;
          const f32x4 w0 = *(const f32x4*)src, w1 = *(const f32x4*)(src + 4); v4u o;
          o.x = pk2(s + 0 <= t ? w0.x : 0.f, s + 1 <= t ? w0.y : 0.f); o.y = pk2(s + 2 <= t ? w0.z : 0.f, s + 3 <= t ? w0.w : 0.f);
          o.z = pk2(s + 4 <= t ? w1.x : 0.f, s + 5 <= t ? w1.y : 0.f); o.w = pk2(s + 6 <= t ? w1.z : 0.f, s + 7 <= t ? w1.w : 0.f);
          *(v4u*)(W16 + (size_t)i * 8) = o; } }
    bf16* HN = (bf16*)(a.ws + WS_HN); float* RINV = (float*)(a.ws + WS_RINV);
    for (int mb = gw * 4; mb < M; mb += NGW * 4) {
        f32x4 v[4][4];
#pragma unroll
        for (int r = 0; r < 4; ++r) { const f32x4* xr = (const f32x4*)(a.x + (size_t)(mb + r) * D) + lane;
#pragma unroll
            for (int j = 0; j < 4; ++j) v[r][j] = xr[64 * j]; }
#pragma unroll
        for (int r = 0; r < 4; ++r) { v2u o[4]; float s = 0.f;
#pragma unroll
            for (int j = 0; j < 4; ++j) { o[j].x = pk2(v[r][j].x, v[r][j].y); o[j].y = pk2(v[r][j].z, v[r][j].w);
                const float a0 = bflo(o[j].x), a1 = bfhi(o[j].x), a2 = bflo(o[j].y), a3 = bfhi(o[j].y); s += (a0 * a0 + a1 * a1) + (a2 * a2 + a3 * a3); }
            const float rr = __builtin_amdgcn_rsqf(wave_sum(s) * (1.f / D) + EPS);
            v2u* o8 = (v2u*)(HN + (size_t)(mb + r) * D) + lane;
#pragma unroll
            for (int j = 0; j < 4; ++j) o8[64 * j] = o[j];
            if (lane == 0) RINV[mb + r] = rr; }
    }
}

__device__ __forceinline__ void row_phase(const bf16* Y, bf16* H, const float* post_g, float* RINV, float* out_final, int gw, int NGW, int lane) {
    f32x4 g[4];
#pragma unroll
    for (int j = 0; j < 4; ++j) g[j] = ((const f32x4*)post_g)[lane + 64 * j];
    for (int mb = gw * 4; mb < M; mb += NGW * 4) {
        v2u yw[4][4], hw[4][4];
#pragma unroll
        for (int r = 0; r < 4; ++r) { const v2u* yr = (const v2u*)(Y + (size_t)(mb + r) * D) + lane; const v2u* hr = (const v2u*)(H + (size_t)(mb + r) * D) + lane;
#pragma unroll
            for (int j = 0; j < 4; ++j) { yw[r][j] = yr[64 * j]; hw[r][j] = hr[64 * j]; } }
#pragma unroll
        for (int r = 0; r < 4; ++r) { const int m = mb + r;
            f32x4 y[4]; float s = 0.f;
#pragma unroll
            for (int j = 0; j < 4; ++j) { y[j] = (f32x4){bflo(yw[r][j].x), bfhi(yw[r][j].x), bflo(yw[r][j].y), bfhi(yw[r][j].y)}; s += (y[j].x * y[j].x + y[j].y * y[j].y) + (y[j].z * y[j].z + y[j].w * y[j].w); }
            const float r1 = __builtin_amdgcn_rsqf(wave_sum(s) * (1.f / D) + EPS);
            if (out_final) {
                f32x4* ho = (f32x4*)(out_final + (size_t)m * D) + lane;
#pragma unroll
                for (int j = 0; j < 4; ++j) { const f32x4 h = (f32x4){bflo(hw[r][j].x), bfhi(hw[r][j].x), bflo(hw[r][j].y), bfhi(hw[r][j].y)}; ho[64 * j] = h + y[j] * r1 * g[j]; }
            } else {
                float s2 = 0.f; v2u* hr = (v2u*)(H + (size_t)m * D) + lane;
#pragma unroll
                for (int j = 0; j < 4; ++j) { const f32x4 h = (f32x4){bflo(hw[r][j].x), bfhi(hw[r][j].x), bflo(hw[r][j].y), bfhi(hw[r][j].y)}; const f32x4 hn = h + y[j] * r1 * g[j];
                    v2u o; o.x = pk2(hn.x, hn.y); o.y = pk2(hn.z, hn.w); hr[64 * j] = o;
                    const float a0 = bflo(o.x), a1 = bfhi(o.x), a2 = bflo(o.y), a3 = bfhi(o.y); s2 += (a0 * a0 + a1 * a1) + (a2 * a2 + a3 * a3); }
                const float r2 = __builtin_amdgcn_rsqf(wave_sum(s2) * (1.f / D) + EPS);
                if (lane == 0) RINV[m] = r2;
            }
        }
    }
}

constexpr int WL_STRIDE = 136;
constexpr int GATE_MAXCH = 32;
__device__ __forceinline__ void gate_phase(const Args& a, int layer, LAS unsigned char* lds, int G, int tid, int wave, int lane) {
    LAS bf16* Wl = (LAS bf16*)lds;
    LAS float* mu_l = (LAS float*)(lds + 128 * WL_STRIDE * 2);
    LAS float* rs_l = mu_l + GATE_MAXCH * 128;
    bf16* U = (bf16*)(a.ws + WS_U); const bf16* Z = (const bf16*)(a.ws + WS_Z); const bf16* VT = (const bf16*)(a.ws + WS_VT);
    const float* ssum = (const float*)(a.ws + WS_STAT); const float* ssq = ssum + (size_t)16 * M;
    const int fr = lane & 15, fq = lane >> 4;
    const int g = blockIdx.x & 7, c0 = blockIdx.x >> 3, cstep = G >> 3;
    {
        const int t = tid >> 2, s0 = (tid & 3) * 32; const float* wsrc = a.a_w_s + (((size_t)layer * 8 + g) * CH + t) * CH + s0;
#pragma unroll
        for (int j = 0; j < 4; ++j) { const f32x4 w0 = *(const f32x4*)(wsrc + 8 * j), w1 = *(const f32x4*)(wsrc + 8 * j + 4); const int s = s0 + 8 * j;
            v4u o; o.x = pk2(s + 0 <= t ? w0.x : 0.f, s + 1 <= t ? w0.y : 0.f); o.y = pk2(s + 2 <= t ? w0.z : 0.f, s + 3 <= t ? w0.w : 0.f);
            o.z = pk2(s + 4 <= t ? w1.x : 0.f, s + 5 <= t ? w1.y : 0.f); o.w = pk2(s + 6 <= t ? w1.z : 0.f, s + 7 <= t ? w1.w : 0.f);
            *(LAS v4u*)(Wl + t * WL_STRIDE + s) = o; }
    }
    {
        int ci = 0;
        for (int chunk = c0; chunk < 512; chunk += cstep, ++ci) {
            if (tid < CH) { const size_t tok = (size_t)chunk * CH + tid; float s = 0.f, q = 0.f;
#pragma unroll
                for (int k = 0; k < 16; ++k) { s += ssum[(size_t)k * M + tok]; q += ssq[(size_t)k * M + tok]; }
                const float mu = s * (1.f / AW); const float var = fmaxf(q * (1.f / AW) - mu * mu, 0.f);
                mu_l[ci * 128 + tid] = mu; rs_l[ci * 128 + tid] = __builtin_amdgcn_rsqf(var + EPS); }
        }
    }
    __syncthreads();
    const int cb = g * 256 + wave * 32;
    float lg[2], lb[2];
#pragma unroll
    for (int n = 0; n < 2; ++n) { const int ch = cb + 8 * (fr >> 2) + 4 * n + (fr & 3); lg[n] = a.a_ln_g[layer * AW + ch]; lb[n] = a.a_ln_b[layer * AW + ch]; }
    const float* bsrc = a.a_b_s + ((size_t)layer * 8 + g) * CH;
    float bs[8];
#pragma unroll
    for (int mb = 0; mb < 8; ++mb) bs[mb] = bsrc[16 * mb + fr];
    int ci = 0;
    for (int chunk = c0; chunk < 512; chunk += cstep, ++ci) {
        const size_t tok0 = (size_t)chunk * CH;
        v4u raw[2][4], u8[8], z8[8];
#pragma unroll
        for (int n = 0; n < 2; ++n) { const int ch = cb + 8 * (fr >> 2) + 4 * n + (fr & 3);
#pragma unroll
            for (int k = 0; k < 4; ++k) raw[n][k] = *(const v4u*)(VT + ((size_t)chunk * AW + ch) * 128 + 32 * k + 8 * fq); }
#pragma unroll
        for (int mb = 0; mb < 8; ++mb) { const size_t off = (tok0 + 16 * mb + fr) * AW + cb + 8 * fq; u8[mb] = *(const v4u*)(U + off); z8[mb] = *(const v4u*)(Z + off); }
        bf16x8 bfr[2][4];
#pragma unroll
        for (int k = 0; k < 4; ++k) { const int s = 32 * k + 8 * fq;
            const f32x4 m0 = *(LAS f32x4*)(mu_l + ci * 128 + s), m1 = *(LAS f32x4*)(mu_l + ci * 128 + s + 4), r0 = *(LAS f32x4*)(rs_l + ci * 128 + s), r1 = *(LAS f32x4*)(rs_l + ci * 128 + s + 4);
#pragma unroll
            for (int n = 0; n < 2; ++n) { const v4u rw = raw[n][k]; const float g_ = lg[n], b_ = lb[n];
                v4u o;
                o.x = pk2((bflo(rw.x) - m0.x) * r0.x * g_ + b_, (bfhi(rw.x) - m0.y) * r0.y * g_ + b_);
                o.y = pk2((bflo(rw.y) - m0.z) * r0.z * g_ + b_, (bfhi(rw.y) - m0.w) * r0.w * g_ + b_);
                o.z = pk2((bflo(rw.z) - m1.x) * r1.x * g_ + b_, (bfhi(rw.z) - m1.y) * r1.y * g_ + b_);
                o.w = pk2((bflo(rw.w) - m1.z) * r1.z * g_ + b_, (bfhi(rw.w) - m1.w) * r1.w * g_ + b_);
                bfr[n][k] = __builtin_bit_cast(bf16x8, o); } }
#pragma unroll
        for (int mb = 0; mb < 8; ++mb) {
            f32x4 acc0 = (f32x4){0.f, 0.f, 0.f, 0.f}, acc1 = (f32x4){0.f, 0.f, 0.f, 0.f};
            const int t = 16 * mb + fr;
#pragma unroll
            for (int k = 0; k < 4; ++k) { if (k <= (mb >> 1)) {
                const bf16x8 af = *(LAS bf16x8*)(Wl + t * WL_STRIDE + 32 * k + 8 * fq);
                acc0 = __builtin_amdgcn_mfma_f32_16x16x32_bf16(bfr[0][k], af, acc0, 0, 0, 0);
                acc1 = __builtin_amdgcn_mfma_f32_16x16x32_bf16(bfr[1][k], af, acc1, 0, 0, 0); } }
            const v4u uu = u8[mb], zz = z8[mb]; const float b_ = bs[mb];
            v4u o;
            o.x = pk2(bflo(uu.x) * (acc0.x + b_) * bflo(zz.x), bfhi(uu.x) * (acc0.y + b_) * bfhi(zz.x));
            o.y = pk2(bflo(uu.y) * (acc0.z + b_) * bflo(zz.y), bfhi(uu.y) * (acc0.w + b_) * bfhi(zz.y));
            o.z = pk2(bflo(uu.z) * (acc1.x + b_) * bflo(zz.z), bfhi(uu.z) * (acc1.y + b_) * bfhi(zz.z));
            o.w = pk2(bflo(uu.w) * (acc1.z + b_) * bflo(zz.w), bfhi(uu.w) * (acc1.w + b_) * bfhi(zz.w));
            *(v4u*)(U + (tok0 + t) * AW + cb + 8 * fq) = o;
        }
    }
    __syncthreads();
}

constexpr int AT_KSTR = 144, AT_VSTR = 528, AT_VOFF = 256 * AT_KSTR;
__device__ __forceinline__ void attn_load_tiles(const bf16* KB, const bf16* VTB, int it, int tid, v4u (&kr)[4], v4u (&vr)[4]) {
    const int kvh = it & 3, qi = (it >> 2) & 31, b = it >> 7;
    const long tokb = (long)b * SEQ + (long)qi * 128; const int gb = b * 32 + qi;
#pragma unroll
    for (int j = 0; j < 4; ++j) { const int c = tid + 512 * j;
        { const int row = c >> 3, part = c & 7;
          kr[j] = (qi == 0 && row < 128) ? (v4u){0u, 0u, 0u, 0u} : *(const v4u*)(KB + (size_t)(tokb - 128 + row) * 256 + kvh * 64 + part * 8); }
        { const int dd = c >> 5, half = (c >> 4) & 1, part = c & 15;
          vr[j] = (qi == 0 && half == 0) ? (v4u){0u, 0u, 0u, 0u} : *(const v4u*)(VTB + ((size_t)(gb - 1 + half) * 256 + kvh * 64 + dd) * 128 + part * 8); } }
}
__device__ __forceinline__ void attn_phase(const Args& a, int layer, LAS unsigned char* lds, int G, int tid, int wave, int lane) {
    bf16* Q = (bf16*)(a.ws + WS_U); const bf16* ZG = Q + (size_t)M * D;
    const bf16* KB = (const bf16*)(a.ws + WS_Z); const bf16* VTB = KB + (size_t)M * 256;
    const int fr = lane & 15, fq = lane >> 4;
    v4u kr[4], vr[4];
    if ((int)blockIdx.x < 2048) attn_load_tiles(KB, VTB, blockIdx.x, tid, kr, vr);
    for (int it = blockIdx.x; it < 2048; it += G) {
        const int kvh = it & 3, qi = (it >> 2) & 31, b = it >> 7;
        const int h = kvh * 4 + (wave >> 1);
        const float slope = __builtin_amdgcn_exp2f(-0.5f * (float)(h + 1)) * LOG2E;
        const float sink = a.b_sinks[layer * 16 + h] * LOG2E;
        const long tokb = (long)b * SEQ + (long)qi * 128;
        bf16x8 qf[4][2];
#pragma unroll
        for (int mb = 0; mb < 4; ++mb) { const size_t qrow = (size_t)(tokb + (wave & 1) * 64 + 16 * mb + fr) * D + h * 64;
            qf[mb][0] = *(const bf16x8*)(Q + qrow + 8 * fq); qf[mb][1] = *(const bf16x8*)(Q + qrow + 8 * fq + 32); }
        f32x4 bias0, bias8; const float b0 = -slope * (float)(128 + fr - 4 * fq);
#pragma unroll
        for (int e = 0; e < 4; ++e) { const int d0 = 128 + fr - 4 * fq - e, d8 = fr - 4 * fq - e; bias0[e] = d0 < 128 ? -slope * (float)d0 : -INFINITY; bias8[e] = d8 >= 0 ? -slope * (float)d8 : -INFINITY; }
        __syncthreads();
#pragma unroll
        for (int j = 0; j < 4; ++j) { const int c = tid + 512 * j;
            *(LAS v4u*)(lds + (c >> 3) * AT_KSTR + (c & 7) * 16) = kr[j];
            *(LAS v4u*)(lds + AT_VOFF + (c >> 5) * AT_VSTR + (((c >> 4) & 1) * 128 + (c & 15) * 8) * 2) = vr[j]; }
        __syncthreads();
        if (it + G < 2048) attn_load_tiles(KB, VTB, it + G, tid, kr, vr);
#pragma unroll
        for (int mb = 0; mb < 4; ++mb) {
            const int t0 = (wave & 1) * 64 + 16 * mb, nb0 = t0 >> 4;
            const size_t orow = (size_t)(tokb + t0 + fr) * D + h * 64 + 4 * fq;
            v2u zz[4];
#pragma unroll
            for (int db = 0; db < 4; ++db) zz[db] = *(const v2u*)(ZG + orow + 16 * db);
            f32x4 S[10]; v4u vfr[2][4];
            const LAS unsigned char* kbase = lds + (16 * nb0 + fr) * AT_KSTR + 16 * fq;
#pragma unroll
            for (int grp = 0; grp < 3; ++grp) {
                bf16x8 kfr[3][2];
#pragma unroll
                for (int j = 0; j < 3; ++j) { const int nb = 3 * grp + j; kfr[j][0] = *(const LAS bf16x8*)(kbase + nb * 16 * AT_KSTR); kfr[j][1] = *(const LAS bf16x8*)(kbase + nb * 16 * AT_KSTR + 64); }
                __builtin_amdgcn_sched_barrier(0);
#pragma unroll
                for (int j = 0; j < 3; ++j) { const int nb = 3 * grp + j; f32x4 z = (f32x4){0.f, 0.f, 0.f, 0.f};
                    z = __builtin_amdgcn_mfma_f32_16x16x32_bf16(kfr[j][0], qf[mb][0], z, 0, 0, 0);
                    S[nb] = __builtin_amdgcn_mfma_f32_16x16x32_bf16(kfr[j][1], qf[mb][1], z, 0, 0, 0); }
                __builtin_amdgcn_sched_barrier(0);
            }
            float mx = sink;
#pragma unroll
            for (int nb = 0; nb < 9; ++nb)
#pragma unroll
                for (int e = 0; e < 4; ++e) S[nb][e] = nb == 0 ? S[nb][e] * LOG2E + bias0[e] : (nb == 8 ? S[nb][e] * LOG2E + bias8[e] : (S[nb][e] * LOG2E + b0) + slope * (float)(16 * nb + e));
            if (qi == 0) {
#pragma unroll
                for (int nb = 0; nb < 9; ++nb)
#pragma unroll
                    for (int e = 0; e < 4; ++e) { const int c = 16 * (nb0 + nb) + 4 * fq + e; S[nb][e] = c >= 128 ? S[nb][e] : -INFINITY; }
            }
#pragma unroll
            for (int nb = 0; nb < 9; ++nb)
#pragma unroll
                for (int e = 0; e < 4; ++e) mx = fmaxf(mx, S[nb][e]);
            mx = fmaxf(mx, __shfl_xor(mx, 16)); mx = fmaxf(mx, __shfl_xor(mx, 32));
            float den = 0.f;
#pragma unroll
            for (int nb = 0; nb < 9; ++nb)
#pragma unroll
                for (int e = 0; e < 4; ++e) { const float p = __builtin_amdgcn_exp2f(S[nb][e] - mx); S[nb][e] = p; den += p; }
            den += __shfl_xor(den, 16); den += __shfl_xor(den, 32);
            den += __builtin_amdgcn_exp2f(sink - mx);
            S[9] = (f32x4){0.f, 0.f, 0.f, 0.f};
            f32x4 O[4];
#pragma unroll
            for (int db = 0; db < 4; ++db) O[db] = (f32x4){0.f, 0.f, 0.f, 0.f};
#define AT_LDV(buf, kk_) do { int kb0 = nb0 + 2 * (kk_), kb1 = kb0 + 1; if (kb0 > 15) kb0 = 15; if (kb1 > 15) kb1 = 15; \
                _Pragma("unroll") for (int db = 0; db < 4; ++db) { const LAS unsigned char* vp = lds + AT_VOFF + (16 * db + fr) * AT_VSTR + 8 * fq; \
                    const v2u v0 = *(const LAS v2u*)(vp + 32 * kb0), v1 = *(const LAS v2u*)(vp + 32 * kb1); vfr[buf][db].x = v0.x; vfr[buf][db].y = v0.y; vfr[buf][db].z = v1.x; vfr[buf][db].w = v1.y; } } while (0)
#define AT_PV(buf, kk_) do { v4u pw; pw.x = pk2(S[2 * (kk_)][0], S[2 * (kk_)][1]); pw.y = pk2(S[2 * (kk_)][2], S[2 * (kk_)][3]); pw.z = pk2(S[2 * (kk_) + 1][0], S[2 * (kk_) + 1][1]); pw.w = pk2(S[2 * (kk_) + 1][2], S[2 * (kk_) + 1][3]); \
                const bf16x8 pb = __builtin_bit_cast(bf16x8, pw); \
                _Pragma("unroll") for (int db = 0; db < 4; ++db) O[db] = __builtin_amdgcn_mfma_f32_16x16x32_bf16(__builtin_bit_cast(bf16x8, vfr[buf][db]), pb, O[db], 0, 0, 0); } while (0)
            AT_LDV(0, 0); AT_LDV(1, 1); AT_PV(0, 0);
            AT_LDV(0, 2); AT_PV(1, 1);
            AT_LDV(1, 3); AT_PV(0, 2);
            AT_LDV(0, 4); AT_PV(1, 3);
            AT_PV(0, 4);
#undef AT_LDV
#undef AT_PV
            const float inv = __builtin_amdgcn_rcpf(den);
#pragma unroll
            for (int db = 0; db < 4; ++db) {
                v2u o; o.x = pk2(O[db][0] * inv * bflo(zz[db].x), O[db][1] * inv * bfhi(zz[db].x)); o.y = pk2(O[db][2] * inv * bflo(zz[db].y), O[db][3] * inv * bfhi(zz[db].y));
                *(v2u*)(Q + orow + 16 * db) = o; }
        }
    }
    __syncthreads();
}

#define XB_TMO      128
#define XB_XCNT(j)  (256  + 64 * (j))
#define XB_XSUB(j)  (1280 + 64 * (j))
#define XB_XGEN(j)  (2304 + 64 * (j))
#define XB_TOP      3328
#define XB_TOPGEN   3392
#define XCD_BAR_WORDS 3456
#define XB_SPIN_CAP (1u << 18)

__device__ __forceinline__ unsigned xb_ld(unsigned* p)              { return __hip_atomic_load(p, __ATOMIC_RELAXED, __HIP_MEMORY_SCOPE_AGENT); }
__device__ __forceinline__ unsigned xb_add(unsigned* p, unsigned v) { return __hip_atomic_fetch_add(p, v, __ATOMIC_RELAXED, __HIP_MEMORY_SCOPE_AGENT); }
__device__ __forceinline__ unsigned xb_xcc_id() { return (unsigned)__builtin_amdgcn_s_getreg((3 << 11) | 20) & 0xFu; }
#define XB_SPIN(cond, bar) do { unsigned _sp = 0; while (cond) { __builtin_amdgcn_s_sleep(1); \
    if ((++_sp & 255u) == 0u) { if (xb_ld(&(bar)[XB_TMO])) break; if (_sp > XB_SPIN_CAP) { atomicAdd(&(bar)[XB_TMO], 1u); break; } } } } while (0)

struct XcdBarrier {
    unsigned* bar; unsigned x;
    volatile LAS unsigned* st;
};

__device__ __forceinline__ XcdBarrier xcd_barrier_post(unsigned* bar, volatile LAS unsigned* st) {
    XcdBarrier b; b.bar = bar; b.x = xb_xcc_id(); b.st = st;
    if (threadIdx.x == 0) (void)xb_add(&bar[XB_XCNT(b.x)], 1u);
    return b;
}
__device__ __forceinline__ void xcd_barrier_complete(unsigned* bar, unsigned x, unsigned& nloc, unsigned& nx) {
    const unsigned G = gridDim.x * gridDim.y * gridDim.z;
    unsigned sum, cnt, mine, sp = 0u;
    for (;;) {
        sum = 0u; cnt = 0u; mine = 0u;
#pragma unroll
        for (unsigned j = 0; j < 16; ++j) { const unsigned c = xb_ld(&bar[XB_XCNT(j)]); sum += c; cnt += (c > 0u) ? 1u : 0u; mine = (j == x) ? c : mine; }
        if (sum == G) break;
        __builtin_amdgcn_s_sleep(1);
        if ((++sp & 255u) == 0u) { if (xb_ld(&bar[XB_TMO])) break; if (sp > XB_SPIN_CAP) { atomicAdd(&bar[XB_TMO], 1u); break; } }
    }
    nloc = mine > 0u ? mine : 1u; nx = cnt > 0u ? cnt : 1u;
}

__device__ __forceinline__ void xcd_barrier(const XcdBarrier& b) {
    asm volatile("s_waitcnt vmcnt(0)" ::: "memory");
    __syncthreads();
    if (threadIdx.x == 0) {
        unsigned* bar = b.bar; asm volatile("" : "+s"(bar));
        __builtin_amdgcn_s_waitcnt(0);
        unsigned nloc = b.st[0], nx = b.st[1];
        if (nloc == 0u) { xcd_barrier_complete(bar, b.x, nloc, nx); b.st[0] = nloc; b.st[1] = nx; }
        const unsigned old = xb_add(&bar[XB_XSUB(b.x)], 1u);
        const unsigned gen = old / nloc;
        if (old + 1u == (gen + 1u) * nloc) {
            __builtin_amdgcn_fence(__ATOMIC_RELEASE, "agent");
            asm volatile("s_waitcnt vmcnt(0)" ::: "memory");
            const unsigned og = xb_add(&bar[XB_TOP], 1u);
            const unsigned tg = og / nx;
            if (og + 1u == (tg + 1u) * nx) xb_add(&bar[XB_TOPGEN], 1u);
            else XB_SPIN(xb_ld(&bar[XB_TOPGEN]) == tg, bar);
            __builtin_amdgcn_fence(__ATOMIC_ACQUIRE, "agent");
            xb_add(&bar[XB_XGEN(b.x)], 1u);
            asm volatile("s_waitcnt vmcnt(0)" ::: "memory");
        } else {
            XB_SPIN(xb_ld(&bar[XB_XGEN(b.x)]) == gen, bar);
            __builtin_amdgcn_fence(__ATOMIC_ACQUIRE, "agent");
            asm volatile("s_waitcnt vmcnt(0)" ::: "memory");
        }
    }
    __syncthreads();
}


__global__ void __launch_bounds__(NWAVES * 64, 2) yoco_fwd(Args a) {
    extern __shared__ __attribute__((aligned(16))) unsigned char lds_raw[];
    LAS unsigned char* lds = (LAS unsigned char*)lds_raw;
    cg::grid_group grid = cg::this_grid();
    if (threadIdx.x < 2) ((volatile LAS unsigned*)(lds + LDS_MISC))[threadIdx.x] = 0u;
    if (blockIdx.x == 0) { for (int i = threadIdx.x; i < XCD_BAR_WORDS; i += NWAVES * 64) ((unsigned*)a.ws + 4096)[i] = 0u; }
    __syncthreads();
#define GRID_BAR() xcd_barrier(xbar)
#define PHASE_IDS() int tid = threadIdx.x; asm volatile("" : "+v"(tid)); const int lane = tid & 63, wave = __builtin_amdgcn_readfirstlane(tid >> 6); const int gw = blockIdx.x * NWAVES + wave; (void)gw; (void)lane
    const int G = gridDim.x, NGW = G * NWAVES;
    bf16* HN = (bf16*)(a.ws + WS_HN);
    bf16* YOUT = (bf16*)(a.ws + WS_VT); float* RINV = (float*)(a.ws + WS_RINV);
#ifdef PROBE_A
    volatile LAS unsigned long long* tsl = (volatile LAS unsigned long long*)(lds + LDS_MISC + 64);
    int n_ts = 0;
#define STAMP() do { if (blockIdx.x == 0 && threadIdx.x == 0) tsl[n_ts] = __builtin_amdgcn_s_memrealtime(); ++n_ts; } while (0)
#else
#define STAMP() do {} while (0)
#endif
    STAMP();

    { PHASE_IDS(); p0_prologue(a, lds, gw, NGW, wave, lane); }
    grid.sync();
    const XcdBarrier xbar = xcd_barrier_post((unsigned*)a.ws + 4096, (volatile LAS unsigned*)(lds + LDS_MISC));
    STAMP();

    { constexpr int l = 0;
        const bf16* Win = (const bf16*)(a.ws + WS_WA_IN) + (size_t)l * 6144 * 1024;
        {
            pg8::Gemm g{HN, Win, M, AW, D}; pg8::StaticOrder S; S.init(M, AW, G, (int)blockIdx.x);
            pg8::EpiUZ E{(bf16*)(a.ws + WS_U), (bf16*)(a.ws + WS_Z), RINV};
            pg8::gemm_phase<pg8::EpiUZ, pg8::StaticOrder, true, true>(lds, g, S, E);
        }
        STAMP();
        {
            pg8::Gemm g{Win + (size_t)4096 * 1024, HN, AW, M, D}; pg8::StaticOrder S; S.init(AW, M, G, (int)blockIdx.x);
            pg8::EpiT<true> E{(bf16*)(a.ws + WS_VT), (float*)(a.ws + WS_STAT), (float*)(a.ws + WS_STAT) + (size_t)16 * M, AW, RINV};
            pg8::gemm_phase<pg8::EpiT<true>, pg8::StaticOrder, true, true>(lds, g, S, E);
        }
        GRID_BAR();
        STAMP();
        {
            PHASE_IDS(); const float* ssum = (const float*)(a.ws + WS_STAT); const float* ssq = ssum + (size_t)16 * M;
            for (int tok = blockIdx.x * 512 + tid; tok < M; tok += G * 512) { float s = 0.f, q = 0.f;
#pragma unroll
                for (int k = 0; k < 16; ++k) { s += ssum[(size_t)k * M + tok]; q += ssq[(size_t)k * M + tok]; }
                const float mu = s * (1.f / AW); const float var = fmaxf(q * (1.f / AW) - mu * mu, 0.f);
                const float rstd = __builtin_amdgcn_rsqf(var + EPS); ((float*)(a.ws + WS_MU))[tok] = -mu * rstd; ((float*)(a.ws + WS_RSTD))[tok] = rstd; }
        }
        GRID_BAR();
        {
            pg8::GroupOrder S{(int)blockIdx.x, G};
            {
                PHASE_IDS(); const int g = ((int)blockIdx.x >> 3) & 7; const bf16* W16 = (const bf16*)(a.ws + WS_W16) + ((size_t)l * 8 + g) * 128 * 128;
                for (int c = tid; c < 20 * 64; c += 512) { const int f = c >> 6, r = (c >> 2) & 15, part = c & 3;
                    int m8 = 0, fb = 0;
#pragma unroll
                    for (int j = 1; j < 8; ++j) { const int b = ((j >> 1) + 1) * ((j >> 1) + (j & 1)); if (f >= b) { m8 = j; fb = b; } }
                    const int k = f - fb;
                    *(LAS v4u*)(lds + LDS_WL + f * 1280 + r * 80 + part * 16) = *(const v4u*)(W16 + (size_t)(16 * m8 + r) * 128 + 32 * k + 8 * part); }
                { pg8::Unit u0; S.next(0, u0); ((LAS float*)(lds + LDS_ST))[tid] = ((const float*)(a.ws + (tid < 256 ? WS_MU : WS_RSTD)))[(size_t)u0.pm * 256 + (tid & 255)]; }
                __syncthreads();
            }
            pg8::Gemm g{HN, Win + (size_t)2048 * 1024, M, AW, D};
            pg8::EpiZGate E{(bf16*)(a.ws + WS_U), (const bf16*)(a.ws + WS_VT), RINV, (const float*)(a.ws + WS_MU), (const float*)(a.ws + WS_RSTD),
                            a.a_ln_g + l * AW, a.a_ln_b + l * AW, a.a_b_s + l * 8 * 128, lds + LDS_WL, lds + LDS_ST, (int)(blockIdx.x >> 6), G >> 6};
            pg8::gemm_phase<pg8::EpiZGate, pg8::GroupOrder, true, true>(lds, g, S, E);
        }
        GRID_BAR();
        STAMP();
        {
            pg8::Gemm g{(const bf16*)(a.ws + WS_U), (const bf16*)(a.ws + WS_WA_OUT) + (size_t)l * 1024 * 2048, M, D, AW}; pg8::StaticOrder S; S.init(M, D, G, (int)blockIdx.x);
            pg8::EpiY16 E{YOUT, D};
            pg8::gemm_phase<pg8::EpiY16, pg8::StaticOrder, true, true>(lds, g, S, E);
        }
        GRID_BAR();
        STAMP();
        { PHASE_IDS(); row_phase(YOUT, HN, a.a_post_g + l * D, RINV, nullptr, gw, NGW, lane); }
        GRID_BAR();
        STAMP();
    }
    { constexpr int l = 1;
        const bf16* Win = (const bf16*)(a.ws + WS_WA_IN) + (size_t)l * 6144 * 1024;
        {
            pg8::Gemm g{HN, Win, M, AW, D}; pg8::StaticOrder S; S.init(M, AW, G, (int)blockIdx.x);
            pg8::EpiUZ E{(bf16*)(a.ws + WS_U), (bf16*)(a.ws + WS_Z), RINV};
            pg8::gemm_phase<pg8::EpiUZ, pg8::StaticOrder, true, true>(lds, g, S, E);
        }
        STAMP();
        {
            pg8::Gemm g{Win + (size_t)4096 * 1024, HN, AW, M, D}; pg8::StaticOrder S; S.init(AW, M, G, (int)blockIdx.x);
            pg8::EpiT<true> E{(bf16*)(a.ws + WS_VT), (float*)(a.ws + WS_STAT), (float*)(a.ws + WS_STAT) + (size_t)16 * M, AW, RINV};
            pg8::gemm_phase<pg8::EpiT<true>, pg8::StaticOrder, true, true>(lds, g, S, E);
        }
        GRID_BAR();
        STAMP();
        {
            PHASE_IDS(); const float* ssum = (const float*)(a.ws + WS_STAT); const float* ssq = ssum + (size_t)16 * M;
            for (int tok = blockIdx.x * 512 + tid; tok < M; tok += G * 512) { float s = 0.f, q = 0.f;
#pragma unroll
                for (int k = 0; k < 16; ++k) { s += ssum[(size_t)k * M + tok]; q += ssq[(size_t)k * M + tok]; }
                const float mu = s * (1.f / AW); const float var = fmaxf(q * (1.f / AW) - mu * mu, 0.f);
                const float rstd = __builtin_amdgcn_rsqf(var + EPS); ((float*)(a.ws + WS_MU))[tok] = -mu * rstd; ((float*)(a.ws + WS_RSTD))[tok] = rstd; }
        }
        GRID_BAR();
        {
            pg8::GroupOrder S{(int)blockIdx.x, G};
            {
                PHASE_IDS(); const int g = ((int)blockIdx.x >> 3) & 7; const bf16* W16 = (const bf16*)(a.ws + WS_W16) + ((size_t)l * 8 + g) * 128 * 128;
                for (int c = tid; c < 20 * 64; c += 512) { const int f = c >> 6, r = (c >> 2) & 15, part = c & 3;
                    int m8 = 0, fb = 0;
#pragma unroll
                    for (int j = 1; j < 8; ++j) { const int b = ((j >> 1) + 1) * ((j >> 1) + (j & 1)); if (f >= b) { m8 = j; fb = b; } }
                    const int k = f - fb;
                    *(LAS v4u*)(lds + LDS_WL + f * 1280 + r * 80 + part * 16) = *(const v4u*)(W16 + (size_t)(16 * m8 + r) * 128 + 32 * k + 8 * part); }
                { pg8::Unit u0; S.next(0, u0); ((LAS float*)(lds + LDS_ST))[tid] = ((const float*)(a.ws + (tid < 256 ? WS_MU : WS_RSTD)))[(size_t)u0.pm * 256 + (tid & 255)]; }
                __syncthreads();
            }
            pg8::Gemm g{HN, Win + (size_t)2048 * 1024, M, AW, D};
            pg8::EpiZGate E{(bf16*)(a.ws + WS_U), (const bf16*)(a.ws + WS_VT), RINV, (const float*)(a.ws + WS_MU), (const float*)(a.ws + WS_RSTD),
                            a.a_ln_g + l * AW, a.a_ln_b + l * AW, a.a_b_s + l * 8 * 128, lds + LDS_WL, lds + LDS_ST, (int)(blockIdx.x >> 6), G >> 6};
            pg8::gemm_phase<pg8::EpiZGate, pg8::GroupOrder, true, true>(lds, g, S, E);
        }
        GRID_BAR();
        STAMP();
        {
            pg8::Gemm g{(const bf16*)(a.ws + WS_U), (const bf16*)(a.ws + WS_WA_OUT) + (size_t)l * 1024 * 2048, M, D, AW}; pg8::StaticOrder S; S.init(M, D, G, (int)blockIdx.x);
            pg8::EpiY16 E{YOUT, D};
            pg8::gemm_phase<pg8::EpiY16, pg8::StaticOrder, true, true>(lds, g, S, E);
        }
        GRID_BAR();
        STAMP();
        { PHASE_IDS(); row_phase(YOUT, HN, a.a_post_g + l * D, RINV, nullptr, gw, NGW, lane); }
        GRID_BAR();
        STAMP();
    }
    { constexpr int l = 0;
        const bf16* Win = (const bf16*)(a.ws + (l ? WS_WB_IN1 : WS_WB_IN0));
        bf16* Q = (bf16*)(a.ws + WS_U); bf16* ZG = Q + (size_t)M * D; bf16* KB = (bf16*)(a.ws + WS_Z); bf16* VTB = KB + (size_t)M * 256;
        {
            const int N = l ? 2048 : 2304;
            pg8::Gemm g{HN, Win, M, N, D}; pg8::StaticOrder S; S.init(M, N, G, (int)blockIdx.x);
            pg8::EpiBin E{a.ws, RINV};
            pg8::gemm_phase<pg8::EpiBin, pg8::StaticOrder, true, true>(lds, g, S, E);
        }
        STAMP();
        if (l == 0) {
            pg8::Gemm g{Win + (size_t)2304 * 1024, HN, 256, M, D}; pg8::StaticOrder S; S.init(256, M, G, (int)blockIdx.x);
            pg8::EpiT<false> E{VTB, nullptr, nullptr, 256, RINV};
            pg8::gemm_phase<pg8::EpiT<false>, pg8::StaticOrder, true, true>(lds, g, S, E);
        }
        GRID_BAR();
        STAMP();
        { PHASE_IDS(); attn_phase(a, l, lds, G, tid, wave, lane); }
        GRID_BAR();
        STAMP();
        {
            pg8::Gemm g{Q, (const bf16*)(a.ws + WS_WB_OUT) + (size_t)l * 1024 * 1024, M, D, D}; pg8::StaticOrder S; S.init(M, D, G, (int)blockIdx.x);
            pg8::EpiY16 E{YOUT, D};
            pg8::gemm_phase<pg8::EpiY16, pg8::StaticOrder, true, true>(lds, g, S, E);
        }
        GRID_BAR();
        STAMP();
        { PHASE_IDS(); row_phase(YOUT, HN, a.b_post_g + l * D, RINV, l == 0 ? nullptr : a.out, gw, NGW, lane); }
        if (l == 0) GRID_BAR();
        STAMP();
    }
    { constexpr int l = 1;
        const bf16* Win = (const bf16*)(a.ws + (l ? WS_WB_IN1 : WS_WB_IN0));
        bf16* Q = (bf16*)(a.ws + WS_U); bf16* ZG = Q + (size_t)M * D; bf16* KB = (bf16*)(a.ws + WS_Z); bf16* VTB = KB + (size_t)M * 256;
        {
            const int N = l ? 2048 : 2304;
            pg8::Gemm g{HN, Win, M, N, D}; pg8::StaticOrder S; S.init(M, N, G, (int)blockIdx.x);
            pg8::EpiBin E{a.ws, RINV};
            pg8::gemm_phase<pg8::EpiBin, pg8::StaticOrder, true, true>(lds, g, S, E);
        }
        STAMP();
        if (l == 0) {
            pg8::Gemm g{Win + (size_t)2304 * 1024, HN, 256, M, D}; pg8::StaticOrder S; S.init(256, M, G, (int)blockIdx.x);
            pg8::EpiT<false> E{VTB, nullptr, nullptr, 256, RINV};
            pg8::gemm_phase<pg8::EpiT<false>, pg8::StaticOrder, true, true>(lds, g, S, E);
        }
        GRID_BAR();
        STAMP();
        { PHASE_IDS(); attn_phase(a, l, lds, G, tid, wave, lane); }
        GRID_BAR();
        STAMP();
        {
            pg8::Gemm g{Q, (const bf16*)(a.ws + WS_WB_OUT) + (size_t)l * 1024 * 1024, M, D, D}; pg8::StaticOrder S; S.init(M, D, G, (int)blockIdx.x);
            pg8::EpiY16 E{YOUT, D};
            pg8::gemm_phase<pg8::EpiY16, pg8::StaticOrder, true, true>(lds, g, S, E);
        }
        GRID_BAR();
        STAMP();
        { PHASE_IDS(); row_phase(YOUT, HN, a.b_post_g + l * D, RINV, l == 0 ? nullptr : a.out, gw, NGW, lane); }
        if (l == 0) GRID_BAR();
        STAMP();
    }
#ifdef PROBE_A
    if (blockIdx.x == 0 && threadIdx.x < 64) {
        asm volatile("s_waitcnt vmcnt(0) lgkmcnt(0)" ::: "memory");
#ifdef PROBE_CONST
        int n = PROBE_CONST;
#else
        int n = (int)((tsl[PROBE_B] - tsl[PROBE_A]) / 100ull);
#endif
        n = n < 0 ? 0 : (n > 16384 ? 16384 : n);
#ifdef PROBE_BIG
        if (threadIdx.x == 0) a.out[0] = 1000.0f * (float)n;
        n = 0;
#endif
        for (int idx = threadIdx.x; idx < n; idx += 64) { float* p = a.out + ((size_t)(idx >> 12) * NGW * 4 + ((idx >> 10) & 3)) * D + (idx & 1023); *p = *p + 0.25f; }
    }
#endif
}

extern "C" void kernel_launch(void* const* d_in, const int* in_sizes, int n_in, void* d_out, int out_size, void* d_ws, size_t ws_size, hipStream_t stream) {
    static int grid = 0;
    if (grid == 0) {
        if (n_in != 17 || in_sizes[0] != M * D || out_size != M * D || ws_size < WS_END) { fprintf(stderr, "kernel_launch: unexpected shapes (n_in %d, in0 %d, out %d, ws %zu)\n", n_in, n_in > 0 ? in_sizes[0] : -1, out_size, ws_size); grid = -1; return; }
        int dev = 0, cus = 0, per_cu = 0;
        hipGetDevice(&dev); hipDeviceGetAttribute(&cus, hipDeviceAttributeMultiprocessorCount, dev);
        if (hipFuncSetAttribute((const void*)yoco_fwd, hipFuncAttributeMaxDynamicSharedMemorySize, LDS_BYTES) != hipSuccess) { fprintf(stderr, "kernel_launch: hipFuncSetAttribute failed\n"); grid = -1; return; }
        if (hipOccupancyMaxActiveBlocksPerMultiprocessor(&per_cu, (const void*)yoco_fwd, NWAVES * 64, LDS_BYTES) != hipSuccess || per_cu < 1) { fprintf(stderr, "kernel_launch: occupancy query says %d\n", per_cu); per_cu = 1; }
        (void)hipGetLastError();
        grid = cus;
        if (grid % 64 != 0) { fprintf(stderr, "kernel_launch: %d CUs; this kernel's unit orders need a multiple of 64\n", cus); grid = -1; return; }
    }
    if (grid < 0) return;
    Args a{};
    a.x = (const float*)d_in[0]; a.a_w_in = (const float*)d_in[1]; a.a_ln_g = (const float*)d_in[2]; a.a_ln_b = (const float*)d_in[3]; a.a_w_s = (const float*)d_in[4];
    a.a_b_s = (const float*)d_in[5]; a.a_w_out = (const float*)d_in[6]; a.a_pre_g = (const float*)d_in[7]; a.a_post_g = (const float*)d_in[8]; a.kv_norm_g = (const float*)d_in[9];
    a.w_k = (const float*)d_in[10]; a.w_v = (const float*)d_in[11]; a.b_w_in = (const float*)d_in[12]; a.b_sinks = (const float*)d_in[13]; a.b_w_out = (const float*)d_in[14];
    a.b_pre_g = (const float*)d_in[15]; a.b_post_g = (const float*)d_in[16];
    a.out = (float*)d_out; a.ws = (unsigned char*)d_ws;
    void* args[] = {&a};
    hipError_t e = hipLaunchCooperativeKernel((const void*)yoco_fwd, dim3(grid), dim3(NWAVES * 64), args, LDS_BYTES, stream);
    if (e != hipSuccess) fprintf(stderr, "kernel_launch: cooperative launch failed: %s (grid %d)\n", hipGetErrorString(e), grid);
}
```

```cpp
#include <hip/hip_runtime.h>
#include <hip/hip_cooperative_groups.h>
#include <cstdio>
#include <cstdint>
namespace cg = cooperative_groups;
namespace pg8 {
#define PG8_LAS __attribute__((address_space(3)))
typedef unsigned short bf16_t;
typedef short bf16x8 __attribute__((ext_vector_type(8)));
typedef float f32x4 __attribute__((ext_vector_type(4)));
typedef unsigned u32x4 __attribute__((ext_vector_type(4)));
constexpr int BM = 256, BK = 64, HALF = 128, HTB = HALF * BK * 2  , STAGE_BYTES = 8 * HTB, NXCD = 8, WGM = 8;

__host__ __device__ __forceinline__ int lds_byte(int r, int c) { const int st = (r >> 4) * 2 + (c >> 5), rr = r & 15, cc = c & 31, ob = rr * 64 + cc * 2; return st * 1024 + (ob ^ (((ob >> 9) & 1) << 5)); }
__host__ __device__ __forceinline__ void stage_rc(int b, int& R, int& C) { const int st = b / 1024, sb = b % 1024, swz = sb ^ (((sb >> 9) & 1) << 5); R = (st >> 1) * 16 + swz / 64; C = (st & 1) * 32 + (swz % 64) / 2; }
__host__ __device__ __forceinline__ int perm32(int rho) { const int n = rho >> 4, i = rho & 15; return 8 * (i >> 2) + 4 * n + (i & 3); }

struct Unit { int pm, pn; };
struct Gemm { const bf16_t* A; const bf16_t* Bt; int M, N, K; };

struct StaticOrder {
    int nM, nN, nwg, G, c;
    __host__ __device__ void init(int M, int N, int G_, int c_) { nM = M / BM; nN = N / BM; nwg = nM * nN; G = G_; c = c_; }
    __host__ __device__ bool next(int i, Unit& u) const {
        const long L = (long)i * G + c; if (L >= nwg) return false;
        int wgid = (int)L; { const int q = nwg / NXCD, r = nwg % NXCD, xcd = wgid % NXCD, off = wgid / NXCD; wgid = (xcd < r ? xcd * (q + 1) : r * (q + 1) + (xcd - r) * q) + off; }
        const int nig = WGM * nN, gid = wgid / nig, fm = gid * WGM, gsz = (nM - fm) < WGM ? (nM - fm) : WGM;
        u.pm = fm + ((wgid % nig) % gsz); u.pn = (wgid % nig) / gsz; return true;
    }
    __device__ __forceinline__ void a_ready(const Unit&) const {}
    __device__ __forceinline__ void done(const Unit&) const {}
};
__device__ __forceinline__ unsigned cvt_pk_bf16(float lo, float hi) { unsigned r; asm volatile("v_cvt_pk_bf16_f32 %0, %1, %2" : "=v"(r) : "v"(lo), "v"(hi)); return r; }
typedef float f32x2 __attribute__((ext_vector_type(2)));
template <class Epi, class Sched, bool ALIGN_EPI = false, bool SP2 = false>
__device__ __forceinline__ void gemm_phase(PG8_LAS unsigned char* lds, const Gemm g, const Sched& S, const Epi& E) {
    int tid_l = threadIdx.x; asm volatile("" : "+v"(tid_l));
    const int tid = tid_l, wid = __builtin_amdgcn_readfirstlane(tid >> 6), lane = tid & 63, wr = wid >> 2, wc = wid & 3, fr = lane & 15, fq = lane >> 4;
    const int K = g.K, nt = K / BK;
    unsigned voffA[2], voffB[2];
#pragma unroll
    for (int i = 0; i < 2; ++i) { int R, C; stage_rc(tid * 16 + i * 8192, R, C); const int Rb = Epi::PERM ? ((R & ~31) + perm32(R & 31)) : R;
        voffA[i] = (unsigned)(R * K + C) * 2u; voffB[i] = (unsigned)(Rb * K + C) * 2u; }
    const size_t kstep = (size_t)(BK * 2);
    const size_t hstep = (size_t)HALF * K * 2;
    const size_t tstep = 2 * hstep;
    const unsigned ldsw = (unsigned)wid * 1024u;
    const int aoff = lds_byte(wr * 64 + fr, fq * 8), boff = lds_byte(wc * 32 + fr, fq * 8);
#define PG8_SA(b, h) (((b) * 2 + (h)) * HTB)
#define PG8_SB(b, h) ((4 + (b) * 2 + (h)) * HTB)
#define PG8_STAGE(bufoff, gbase, voff) do { _Pragma("unroll") for (int _i = 0; _i < 2; ++_i) \
        __builtin_amdgcn_global_load_lds((const unsigned*)((const char*)(gbase) + (voff)[_i]), (PG8_LAS unsigned*)(lds + (bufoff) + ldsw + _i * 8192), 16, 0, 0); } while (0)
#define PG8_LDA(dst, b, h) do { _Pragma("unroll") for (int m = 0; m < 4; ++m) _Pragma("unroll") for (int k = 0; k < 2; ++k) dst[m][k] = *(const PG8_LAS bf16x8*)(lds + PG8_SA(b, h) + aoff + m * 2048 + k * 1024); } while (0)
#define PG8_LDB(dst, b, h) do { _Pragma("unroll") for (int n = 0; n < 2; ++n) _Pragma("unroll") for (int k = 0; k < 2; ++k) dst[n][k] = *(const PG8_LAS bf16x8*)(lds + PG8_SB(b, h) + boff + n * 2048 + k * 1024); } while (0)
#define PG8_MMA(ai, bj, At, Bt) do { __builtin_amdgcn_s_setprio(1); _Pragma("unroll") for (int m = 0; m < 4; ++m) _Pragma("unroll") for (int n = 0; n < 2; ++n) _Pragma("unroll") for (int k = 0; k < 2; ++k) \
        acc[ai][bj][m][n] = __builtin_amdgcn_mfma_f32_16x16x32_bf16(Bt[n][k], At[m][k], acc[ai][bj][m][n], 0, 0, 0); __builtin_amdgcn_s_setprio(0); } while (0)
#define PG8_WAIT_V(n) asm volatile("s_waitcnt vmcnt(" #n ")" ::: "memory")
#define PG8_WAIT_L(n) asm volatile("s_waitcnt lgkmcnt(" #n ")" ::: "memory")
#define PG8_BAR __builtin_amdgcn_s_barrier()
#define PG8_SCHED __builtin_amdgcn_sched_barrier(0)
    Unit cur, nxt; int ui = 0;
    if (!S.next(0, cur)) return;
    f32x4 acc[2][2][4][2];
#pragma unroll
    for (int a = 0; a < 2; ++a)
#pragma unroll
        for (int b = 0; b < 2; ++b)
#pragma unroll
            for (int m = 0; m < 4; ++m)
#pragma unroll
                for (int n = 0; n < 2; ++n) acc[a][b][m][n] = (f32x4){0.f, 0.f, 0.f, 0.f};
    bf16x8 At[4][2], B0[2][2], B1[2][2];
    const char* cA = (const char*)g.A + (size_t)cur.pm * tstep; const char* cB = (const char*)g.Bt + (size_t)cur.pn * tstep;
    S.a_ready(cur);
    if constexpr (SP2) {
        PG8_STAGE(PG8_SB(0, 0), cB, voffB); PG8_STAGE(PG8_SB(0, 1), cB + hstep, voffB); PG8_STAGE(PG8_SA(0, 0), cA, voffA); PG8_STAGE(PG8_SA(0, 1), cA + hstep, voffA);
        if (wr == 1) PG8_BAR;
        PG8_WAIT_V(2); PG8_BAR;
        PG8_STAGE(PG8_SB(1, 0), cB + kstep, voffB); PG8_STAGE(PG8_SA(1, 0), cA + kstep, voffA); PG8_STAGE(PG8_SB(1, 1), cB + hstep + kstep, voffB);
        PG8_WAIT_V(6); PG8_BAR;
    } else {
        PG8_STAGE(PG8_SB(0, 0), cB, voffB); PG8_STAGE(PG8_SA(0, 0), cA, voffA); PG8_STAGE(PG8_SB(0, 1), cB + hstep, voffB); PG8_STAGE(PG8_SA(0, 1), cA + hstep, voffA);
        if (wr == 1) PG8_BAR;
        PG8_WAIT_V(4); PG8_BAR;
        PG8_STAGE(PG8_SB(1, 0), cB + kstep, voffB); PG8_STAGE(PG8_SA(1, 0), cA + kstep, voffA); PG8_STAGE(PG8_SB(1, 1), cB + hstep + kstep, voffB);
        PG8_WAIT_V(6); PG8_BAR;
    }
    for (;;) {
        const bool has_next = S.next(ui + 1, nxt);
        const char* nA = has_next ? (const char*)g.A + (size_t)nxt.pm * tstep : cA; const char* nB = has_next ? (const char*)g.Bt + (size_t)nxt.pn * tstep : cB;
        for (int t = 0; t < nt; t += 2) {
            const bool last = (t == nt - 2);
            const char* a1 = cA + (size_t)(t + 1) * kstep;
            const char* a2 = last ? nA : cA + (size_t)(t + 2) * kstep; const char* b2 = last ? nB : cB + (size_t)(t + 2) * kstep;
            const char* a3 = a2 + kstep; const char* b3 = b2 + kstep;
            if (last && has_next) S.a_ready(nxt);
            if constexpr (SP2) {
            PG8_LDB(B0, 0, 0); PG8_LDB(B1, 0, 1); PG8_SCHED; PG8_LDA(At, 0, 0); PG8_STAGE(PG8_SA(1, 1), a1 + hstep, voffA);
            PG8_WAIT_V(8); PG8_WAIT_L(0); PG8_BAR; PG8_MMA(0, 0, At, B0); PG8_MMA(0, 1, At, B1); PG8_BAR; PG8_SCHED;
            PG8_LDA(At, 0, 1); PG8_STAGE(PG8_SB(0, 0), b2, voffB); PG8_STAGE(PG8_SB(0, 1), b2 + hstep, voffB); PG8_STAGE(PG8_SA(0, 0), a2, voffA);
            PG8_WAIT_V(8); PG8_WAIT_L(0); PG8_BAR; PG8_MMA(1, 0, At, B0); PG8_MMA(1, 1, At, B1); PG8_BAR; PG8_SCHED;
            PG8_LDB(B0, 1, 0); PG8_LDB(B1, 1, 1); PG8_SCHED; PG8_LDA(At, 1, 0); PG8_STAGE(PG8_SA(0, 1), a2 + hstep, voffA);
            PG8_WAIT_V(8); PG8_WAIT_L(0); PG8_BAR; PG8_MMA(0, 0, At, B0); PG8_MMA(0, 1, At, B1); PG8_BAR; PG8_SCHED;
            PG8_LDA(At, 1, 1); PG8_STAGE(PG8_SB(1, 0), b3, voffB); PG8_STAGE(PG8_SB(1, 1), b3 + hstep, voffB); PG8_STAGE(PG8_SA(1, 0), a3, voffA);
            PG8_WAIT_V(8); PG8_WAIT_L(0); PG8_BAR; PG8_MMA(1, 0, At, B0); PG8_MMA(1, 1, At, B1); PG8_BAR; PG8_SCHED;
            } else {
            PG8_LDB(B0, 0, 0); PG8_SCHED; PG8_LDA(At, 0, 0); PG8_STAGE(PG8_SA(1, 1), a1 + hstep, voffA);
            PG8_WAIT_L(8); PG8_BAR; PG8_WAIT_L(0); PG8_MMA(0, 0, At, B0); PG8_BAR; PG8_SCHED;
            PG8_LDB(B1, 0, 1); PG8_STAGE(PG8_SB(0, 0), b2, voffB);
            PG8_BAR; PG8_WAIT_L(0); PG8_MMA(0, 1, At, B1); PG8_BAR;
            PG8_LDA(At, 0, 1); PG8_STAGE(PG8_SA(0, 0), a2, voffA);
            PG8_BAR; PG8_WAIT_L(0); PG8_MMA(1, 0, At, B0); PG8_BAR; PG8_SCHED;
            PG8_STAGE(PG8_SB(0, 1), b2 + hstep, voffB);
            PG8_WAIT_V(6); PG8_BAR; PG8_MMA(1, 1, At, B1); PG8_BAR;
            PG8_LDB(B0, 1, 0); PG8_SCHED; PG8_LDA(At, 1, 0); PG8_STAGE(PG8_SA(0, 1), a2 + hstep, voffA);
            PG8_WAIT_L(8); PG8_BAR; PG8_WAIT_L(0); PG8_MMA(0, 0, At, B0); PG8_BAR; PG8_SCHED;
            PG8_LDB(B1, 1, 1); PG8_STAGE(PG8_SB(1, 0), b3, voffB);
            PG8_BAR; PG8_WAIT_L(0); PG8_MMA(0, 1, At, B1); PG8_BAR;
            PG8_LDA(At, 1, 1); PG8_STAGE(PG8_SA(1, 0), a3, voffA);
            PG8_BAR; PG8_WAIT_L(0); PG8_MMA(1, 0, At, B0); PG8_BAR; PG8_SCHED;
            PG8_STAGE(PG8_SB(1, 1), b3 + hstep, voffB);
            PG8_WAIT_V(6); PG8_BAR; PG8_MMA(1, 1, At, B1); PG8_BAR;
            }
        }
        if constexpr (ALIGN_EPI) { if (wr == 0) PG8_BAR; }
        if constexpr (!Epi::AFTER_DRAIN) { E(acc, cur, wr, wc, fr, fq); S.done(cur); }
        if (!has_next) break;
#pragma unroll
        for (int a = 0; a < 2; ++a)
#pragma unroll
            for (int b = 0; b < 2; ++b)
#pragma unroll
                for (int m = 0; m < 4; ++m)
#pragma unroll
                    for (int n = 0; n < 2; ++n) acc[a][b][m][n] = (f32x4){0.f, 0.f, 0.f, 0.f};
        cur = nxt; cA = nA; cB = nB; ++ui;
        if constexpr (ALIGN_EPI) { if (wr == 1) PG8_BAR; }
    }
    PG8_WAIT_V(0);
    if constexpr (!ALIGN_EPI) { if (wr == 0) PG8_BAR; }
    PG8_BAR;
    if constexpr (Epi::AFTER_DRAIN) { E.fused(acc, cur, wr, wc, fr, fq, lds, wid, lane); S.done(cur); }
#undef PG8_SA
#undef PG8_SB
#undef PG8_STAGE
#undef PG8_LDA
#undef PG8_LDB
#undef PG8_MMA
#undef PG8_WAIT_V
#undef PG8_WAIT_L
#undef PG8_BAR
#undef PG8_SCHED
}
}


constexpr int NWAVES = 8;
constexpr int M = 65536, D = 1024, AW = 2048, SEQ = 4096, CH = 128;
constexpr float EPS = 1e-6f;
constexpr size_t MiB = 1u << 20;
constexpr size_t WS_WA_IN = 1 * MiB;
constexpr size_t WS_WA_OUT = 25 * MiB;
constexpr size_t WS_WB_IN0 = 33 * MiB;
constexpr size_t WS_WB_IN1 = 38 * MiB;
constexpr size_t WS_WB_OUT = 42 * MiB;
constexpr size_t WS_STAT = 46 * MiB;
constexpr size_t WS_RINV = 54 * MiB;
constexpr size_t WS_W16 = 55 * MiB;
constexpr size_t WS_MU = 56 * MiB;
constexpr size_t WS_RSTD = 57 * MiB;
constexpr size_t WS_HN = 64 * MiB;
constexpr size_t WS_U = 192 * MiB;
constexpr size_t WS_VT = 448 * MiB;
constexpr size_t WS_Z = 704 * MiB;
constexpr size_t WS_END = 960 * MiB;
constexpr int LDS_WL = 131072, LDS_WL_BYTES = 20 * 1280;
constexpr int LDS_MISC = LDS_WL + LDS_WL_BYTES;
constexpr int LDS_ST = LDS_MISC + 512;
constexpr int LDS_BYTES = LDS_ST + 4096;

#define LAS __attribute__((address_space(3)))
typedef unsigned short bf16;
typedef unsigned v4u __attribute__((ext_vector_type(4)));
typedef unsigned v2u __attribute__((ext_vector_type(2)));
typedef float f32x4 __attribute__((ext_vector_type(4)));
typedef short bf16x8 __attribute__((ext_vector_type(8)));
typedef short bf16x4 __attribute__((ext_vector_type(4)));

__device__ __forceinline__ unsigned f2bf(float f) { unsigned u = __builtin_bit_cast(unsigned, f); return (u + 0x7fffu + ((u >> 16) & 1u)) >> 16; }
__device__ __forceinline__ unsigned pk2(float lo, float hi) { return pg8::cvt_pk_bf16(lo, hi); }
__device__ __forceinline__ float bflo(unsigned w) { return __builtin_bit_cast(float, w << 16); }
__device__ __forceinline__ float bfhi(unsigned w) { return __builtin_bit_cast(float, w & 0xffff0000u); }
__device__ __forceinline__ float wave_sum(float v) {
#pragma unroll
    for (int o = 1; o < 64; o <<= 1) v += __shfl_xor(v, o);
    return v;
}
__device__ __forceinline__ float act_sig(float x, float c1n, float c3n) {
    const float t = x * (c1n + c3n * x * x);
    return x * __builtin_amdgcn_rcpf(1.0f + __builtin_amdgcn_exp2f(t));
}
__device__ __forceinline__ float row16_sum(float v) {
    v += __builtin_bit_cast(float, __builtin_amdgcn_update_dpp(0, __builtin_bit_cast(int, v), 0xB1, 0xF, 0xF, false));
    v += __builtin_bit_cast(float, __builtin_amdgcn_update_dpp(0, __builtin_bit_cast(int, v), 0x4E, 0xF, 0xF, false));
    v += __builtin_bit_cast(float, __builtin_amdgcn_update_dpp(0, __builtin_bit_cast(int, v), 0x141, 0xF, 0xF, false));
    v += __builtin_bit_cast(float, __builtin_amdgcn_update_dpp(0, __builtin_bit_cast(int, v), 0x140, 0xF, 0xF, false));
    return v;
}
__device__ __forceinline__ float silu_f(float x) { return x * __builtin_amdgcn_rcpf(1.0f + __builtin_amdgcn_exp2f(x * -1.4426950408889634f)); }
constexpr float LOG2E = 1.4426950408889634f;
constexpr float GELU_C1N = -1.5957691216057308f * LOG2E, GELU_C3N = -0.07135481627f * LOG2E, SILU_C1N = -LOG2E;

namespace pg8 {
struct EpiUZ {
    static constexpr bool PERM = true, AFTER_DRAIN = false;
    bf16_t* U; bf16_t* Z; const float* rinv;
    __device__ __forceinline__ void operator()(const f32x4 (&acc)[2][2][4][2], const Unit& u, int wr, int wc, int fr, int fq) const {
        const bool isz = u.pn >= 8; bf16_t* base = isz ? Z : U;
        const float c1 = isz ? SILU_C1N : GELU_C1N, c3 = isz ? 0.f : GELU_C3N;
        const int row0 = u.pm * BM + wr * 64 + fr, col0 = (u.pn & 7) * BM + wc * 32 + 8 * fq;
#pragma unroll
        for (int ai = 0; ai < 2; ++ai)
#pragma unroll
            for (int m = 0; m < 4; ++m) { bf16_t* rowp = base + (size_t)(row0 + ai * HALF + m * 16) * AW + col0; const float rs = rinv[row0 + ai * HALF + m * 16];
#pragma unroll
                for (int bj = 0; bj < 2; ++bj) { const f32x4 v0 = acc[ai][bj][m][0] * rs, v1 = acc[ai][bj][m][1] * rs; u32x4 w;
                    w.x = cvt_pk_bf16(act_sig(v0[0], c1, c3), act_sig(v0[1], c1, c3)); w.y = cvt_pk_bf16(act_sig(v0[2], c1, c3), act_sig(v0[3], c1, c3));
                    w.z = cvt_pk_bf16(act_sig(v1[0], c1, c3), act_sig(v1[1], c1, c3)); w.w = cvt_pk_bf16(act_sig(v1[2], c1, c3), act_sig(v1[3], c1, c3));
                    __builtin_nontemporal_store(w, (u32x4*)(rowp + bj * HALF)); } }
    }
};
template <bool GELU> struct EpiT {
    static constexpr bool PERM = true, AFTER_DRAIN = false;
    bf16_t* OT; float* ssum; float* ssq; int nch; const float* rinv;
    __device__ __forceinline__ void operator()(const f32x4 (&acc)[2][2][4][2], const Unit& u, int wr, int wc, int fr, int fq) const {
        const int row0 = u.pm * BM + wr * 64 + fr, col0 = u.pn * BM + wc * 32 + 8 * fq;
        f32x4 s[2][2], q[2][2], rs[2][2];
#pragma unroll
        for (int bj = 0; bj < 2; ++bj)
#pragma unroll
            for (int n = 0; n < 2; ++n) { s[bj][n] = (f32x4){0.f, 0.f, 0.f, 0.f}; q[bj][n] = (f32x4){0.f, 0.f, 0.f, 0.f}; rs[bj][n] = *(const f32x4*)(rinv + col0 + bj * HALF + 4 * n); }
#pragma unroll
        for (int ai = 0; ai < 2; ++ai)
#pragma unroll
            for (int m = 0; m < 4; ++m) { bf16_t* rowp = OT + ((size_t)(u.pn * 2) * nch + (row0 + ai * HALF + m * 16)) * 128 + wc * 32 + 8 * fq;
#pragma unroll
                for (int bj = 0; bj < 2; ++bj) { f32x4 v0 = acc[ai][bj][m][0] * rs[bj][0], v1 = acc[ai][bj][m][1] * rs[bj][1];
                    if (GELU) {
#pragma unroll
                        for (int j = 0; j < 4; ++j) { v0[j] = act_sig(v0[j], GELU_C1N, GELU_C3N); v1[j] = act_sig(v1[j], GELU_C1N, GELU_C3N); }
                        s[bj][0] += v0; s[bj][1] += v1; q[bj][0] += v0 * v0; q[bj][1] += v1 * v1; }
                    u32x4 w; w.x = cvt_pk_bf16(v0[0], v0[1]); w.y = cvt_pk_bf16(v0[2], v0[3]); w.z = cvt_pk_bf16(v1[0], v1[1]); w.w = cvt_pk_bf16(v1[2], v1[3]);
                    __builtin_nontemporal_store(w, (u32x4*)(rowp + (size_t)bj * nch * 128)); } }
        if (GELU) {
#pragma unroll
            for (int bj = 0; bj < 2; ++bj)
#pragma unroll
                for (int n = 0; n < 2; ++n)
#pragma unroll
                    for (int j = 0; j < 4; ++j) { s[bj][n][j] = row16_sum(s[bj][n][j]); q[bj][n][j] = row16_sum(q[bj][n][j]); }
            if (fr == 0) { const size_t slot = (size_t)(u.pm * 2 + wr) * M + col0;
#pragma unroll
                for (int bj = 0; bj < 2; ++bj)
#pragma unroll
                    for (int n = 0; n < 2; ++n) { *(f32x4*)(ssum + slot + bj * HALF + 4 * n) = s[bj][n]; *(f32x4*)(ssq + slot + bj * HALF + 4 * n) = q[bj][n]; } }
        }
    }
};
struct EpiBin {
    static constexpr bool PERM = true, AFTER_DRAIN = false;
    unsigned char* ws; const float* rinv;
    __device__ __forceinline__ void operator()(const f32x4 (&acc)[2][2][4][2], const Unit& u, int wr, int wc, int fr, int fq) const {
        const bool isz = (u.pn >= 4) && (u.pn < 8); const bool isk = u.pn >= 8;
        const size_t boff = isk ? (size_t)(WS_Z) : (isz ? (size_t)(WS_U + (size_t)M * D * 2) : (size_t)WS_U);
        bf16_t* base = (bf16_t*)(ws + boff); const int ldc = isk ? 256 : 1024;
        const int row0 = u.pm * BM + wr * 64 + fr, col0 = (isk ? 0 : (u.pn & 3) * BM) + wc * 32 + 8 * fq;
#pragma unroll
        for (int ai = 0; ai < 2; ++ai)
#pragma unroll
            for (int m = 0; m < 4; ++m) { bf16_t* rowp = base + (size_t)(row0 + ai * HALF + m * 16) * ldc + col0; const float rs = rinv[row0 + ai * HALF + m * 16];
#pragma unroll
                for (int bj = 0; bj < 2; ++bj) { f32x4 v0 = acc[ai][bj][m][0] * rs, v1 = acc[ai][bj][m][1] * rs;
                    if (isz) { v0 = (f32x4){silu_f(v0.x), silu_f(v0.y), silu_f(v0.z), silu_f(v0.w)};
                        v1 = (f32x4){silu_f(v1.x), silu_f(v1.y), silu_f(v1.z), silu_f(v1.w)}; }
                    u32x4 w; w.x = cvt_pk_bf16(v0[0], v0[1]); w.y = cvt_pk_bf16(v0[2], v0[3]); w.z = cvt_pk_bf16(v1[0], v1[1]); w.w = cvt_pk_bf16(v1[2], v1[3]);
                    __builtin_nontemporal_store(w, (u32x4*)(rowp + bj * HALF)); } }
    }
};
struct GroupOrder {
    int c, G;
    __device__ __forceinline__ bool next(int i, Unit& u) const { const int J8 = G >> 6, j = c >> 3, off = (j >> 3) + J8 * i; if (off >= 32) return false; u.pn = j & 7; u.pm = 32 * (c & 7) + off; return true; }
    __device__ __forceinline__ void a_ready(const Unit&) const {}
    __device__ __forceinline__ void done(const Unit&) const {}
};
struct EpiZGate {
    static constexpr bool PERM = true, AFTER_DRAIN = false;
    bf16_t* U; const bf16_t* VT; const float* rinv; const float* mu; const float* rstd;
    const float* lng; const float* lnb; const float* bsv; PG8_LAS unsigned char* wl; PG8_LAS unsigned char* st; int off0, J8;
    __device__ __forceinline__ void load_raw(u32x4 (&raw)[2][4], int chunk, int cb, int wr, int fr, int fq) const {
#pragma unroll
        for (int n = 0; n < 2; ++n) { const int ch = cb + 8 * (fr >> 2) + 4 * n + (fr & 3); const bf16_t* vp = VT + ((size_t)chunk * 2048 + ch) * 128 + 8 * fq;
#pragma unroll
            for (int k = 0; k < 4; ++k) { if (k <= 2 * wr + 1) raw[n][k] = *(const u32x4*)(vp + 32 * k); } }
    }
    __device__ __forceinline__ void operator()(const f32x4 (&acc)[2][2][4][2], const Unit& u, int wr, int wc, int fr_in, int fq_in) const {
        const int g = u.pn;
        const int uidx = ((u.pm & 31) - off0) / J8; const PG8_LAS unsigned char* stc = st + (uidx & 1) * 2048; PG8_LAS unsigned char* stn = st + ((uidx + 1) & 1) * 2048;
        asm volatile("s_waitcnt lgkmcnt(0)" ::: "memory"); __builtin_amdgcn_s_barrier(); asm volatile("" ::: "memory");
        float stnext;
        { const int tid = (wr * 4 + wc) * 64 + fq_in * 16 + fr_in; int pmn = u.pm + J8; if ((pmn & 31) < (u.pm & 31)) pmn = u.pm;
          stnext = (tid < 256 ? mu : rstd)[(size_t)pmn * 256 + (tid & 255)]; }
        u32x4 raw[2][4], zs[4][4], un[4]; float bs[4], lgn[2], lbn[2];
        {
            int fr = fr_in, fq = fq_in; asm volatile("" : "+v"(fr), "+v"(fq));
            float rs1[4], rs0[4];
#pragma unroll
            for (int m = 0; m < 4; ++m) { const int t = 64 * wr + 16 * m + fr; rs1[m] = rinv[(size_t)(2 * u.pm + 1) * 128 + t]; rs0[m] = rinv[(size_t)(2 * u.pm) * 128 + t]; bs[m] = bsv[g * 128 + t]; }
#pragma unroll
            for (int n = 0; n < 2; ++n) { const int ch = g * 256 + 32 * wc + 8 * (fr >> 2) + 4 * n + (fr & 3); lgn[n] = lng[ch]; lbn[n] = lnb[ch]; }
            asm volatile("" ::: "memory");
            load_raw(raw, 2 * u.pm, g * 256 + 32 * wc, wr, fr, fq);
#pragma unroll
            for (int m = 0; m < 4; ++m) un[m] = *(const u32x4*)(U + ((size_t)(2 * u.pm) * 128 + 64 * wr + 16 * m + fr) * AW + g * 256 + 32 * wc + 8 * fq);
            asm volatile("" ::: "memory");
#pragma unroll
            for (int blk = 0; blk < 4; ++blk)
#pragma unroll
                for (int m = 0; m < 4; ++m) { const float r_ = (blk >> 1) ? rs1[m] : rs0[m]; const f32x4 z0 = acc[blk >> 1][blk & 1][m][0] * r_, z1 = acc[blk >> 1][blk & 1][m][1] * r_;
                    zs[blk][m].x = cvt_pk_bf16(silu_f(z0.x), silu_f(z0.y)); zs[blk][m].y = cvt_pk_bf16(silu_f(z0.z), silu_f(z0.w));
                    zs[blk][m].z = cvt_pk_bf16(silu_f(z1.x), silu_f(z1.y)); zs[blk][m].w = cvt_pk_bf16(silu_f(z1.z), silu_f(z1.w)); }
        }
#pragma unroll
        for (int blk = 0; blk < 4; ++blk) {
            const int ai = blk >> 1, bj = blk & 1;
            const int chunk = 2 * u.pm + ai; const size_t tok0 = (size_t)chunk * 128;
            const int cb = g * 256 + 128 * bj + 32 * wc;
            int fr = fr_in, fq = fq_in; asm volatile("" : "+v"(fr), "+v"(fq));
            u32x4 uu[4], vf[2][4]; float lg[2], lb[2];
#pragma unroll
            for (int m = 0; m < 4; ++m) uu[m] = un[m];
#pragma unroll
            for (int n = 0; n < 2; ++n) { lg[n] = lgn[n]; lb[n] = lbn[n]; }
#pragma unroll
            for (int k = 0; k < 4; ++k) { if (k <= 2 * wr + 1) { const int s = 32 * k + 8 * fq;
                const PG8_LAS float* sp = (const PG8_LAS float*)stc + ai * 128 + s;
                const f32x4 m0 = *(const PG8_LAS f32x4*)sp, m1 = *(const PG8_LAS f32x4*)(sp + 4), r0 = *(const PG8_LAS f32x4*)(sp + 256), r1 = *(const PG8_LAS f32x4*)(sp + 260);
#pragma unroll
                for (int n = 0; n < 2; ++n) { const u32x4 rw = raw[n][k]; const float g_ = lg[n], b_ = lb[n]; u32x4 o;
                    o.x = cvt_pk_bf16((bflo(rw.x) * r0.x + m0.x) * g_ + b_, (bfhi(rw.x) * r0.y + m0.y) * g_ + b_);
                    o.y = cvt_pk_bf16((bflo(rw.y) * r0.z + m0.z) * g_ + b_, (bfhi(rw.y) * r0.w + m0.w) * g_ + b_);
                    o.z = cvt_pk_bf16((bflo(rw.z) * r1.x + m1.x) * g_ + b_, (bfhi(rw.z) * r1.y + m1.y) * g_ + b_);
                    o.w = cvt_pk_bf16((bflo(rw.w) * r1.z + m1.z) * g_ + b_, (bfhi(rw.w) * r1.w + m1.w) * g_ + b_);
                    vf[n][k] = o; } } }
            asm volatile("" ::: "memory");
            if (blk < 3) { const int nb = blk + 1; load_raw(raw, 2 * u.pm + (nb >> 1), g * 256 + 128 * (nb & 1) + 32 * wc, wr, fr, fq);
#pragma unroll
                for (int m = 0; m < 4; ++m) un[m] = *(const u32x4*)(U + ((size_t)(2 * u.pm + (nb >> 1)) * 128 + 64 * wr + 16 * m + fr) * AW + g * 256 + 128 * (nb & 1) + 32 * wc + 8 * fq);
#pragma unroll
                for (int n = 0; n < 2; ++n) { const int ch = g * 256 + 128 * (nb & 1) + 32 * wc + 8 * (fr >> 2) + 4 * n + (fr & 3); lgn[n] = lng[ch]; lbn[n] = lnb[ch]; } }
            asm volatile("" ::: "memory");
#pragma unroll
            for (int m = 0; m < 4; ++m) {
                const int m8 = 4 * wr + m, p = m8 >> 1, kmax = p, fbase = (p + 1) * (p + (m8 & 1));
                const PG8_LAS unsigned char* wp = wl + fbase * 1280 + fr * 80 + fq * 16;
                f32x4 s0 = (f32x4){0.f, 0.f, 0.f, 0.f}, s1 = (f32x4){0.f, 0.f, 0.f, 0.f};
#pragma unroll
                for (int kp = 0; kp < 2; ++kp) {
                    bf16x8 wfr[2];
#pragma unroll
                    for (int q = 0; q < 2; ++q) { if (2 * kp + q <= kmax) wfr[q] = *(const PG8_LAS bf16x8*)(wp + (2 * kp + q) * 1280); }
#pragma unroll
                    for (int q = 0; q < 2; ++q) { if (2 * kp + q <= kmax) {
                        s0 = __builtin_amdgcn_mfma_f32_16x16x32_bf16(__builtin_bit_cast(bf16x8, vf[0][2 * kp + q]), wfr[q], s0, 0, 0, 0);
                        s1 = __builtin_amdgcn_mfma_f32_16x16x32_bf16(__builtin_bit_cast(bf16x8, vf[1][2 * kp + q]), wfr[q], s1, 0, 0, 0); } } }
                const float b_ = bs[m]; const u32x4 ux = uu[m];
                f32x4 g0, g1;
                { const u32x4 zz = zs[blk][m]; g0 = (f32x4){bflo(zz.x), bfhi(zz.x), bflo(zz.y), bfhi(zz.y)}; g1 = (f32x4){bflo(zz.z), bfhi(zz.z), bflo(zz.w), bfhi(zz.w)}; }
                u32x4 o;
                o.x = cvt_pk_bf16(bflo(ux.x) * (s0.x + b_) * g0.x, bfhi(ux.x) * (s0.y + b_) * g0.y);
                o.y = cvt_pk_bf16(bflo(ux.y) * (s0.z + b_) * g0.z, bfhi(ux.y) * (s0.w + b_) * g0.w);
                o.z = cvt_pk_bf16(bflo(ux.z) * (s1.x + b_) * g1.x, bfhi(ux.z) * (s1.y + b_) * g1.y);
                o.w = cvt_pk_bf16(bflo(ux.w) * (s1.z + b_) * g1.z, bfhi(ux.w) * (s1.w + b_) * g1.w);
                *(u32x4*)(U + (tok0 + 64 * wr + 16 * m + fr) * AW + cb + 8 * fq) = o;
            }
        }
        { const int tid = (wr * 4 + wc) * 64 + fq_in * 16 + fr_in; ((PG8_LAS float*)stn)[tid] = stnext; }
    }
};
struct EpiY16 {
    static constexpr bool PERM = true, AFTER_DRAIN = false;
    bf16_t* C; int ldc;
    __device__ __forceinline__ void operator()(const f32x4 (&acc)[2][2][4][2], const Unit& u, int wr, int wc, int fr, int fq) const {
        const int row0 = u.pm * BM + wr * 64 + fr, col0 = u.pn * BM + wc * 32 + 8 * fq;
#pragma unroll
        for (int ai = 0; ai < 2; ++ai)
#pragma unroll
            for (int m = 0; m < 4; ++m) { bf16_t* rowp = C + (size_t)(row0 + ai * HALF + m * 16) * ldc + col0;
#pragma unroll
                for (int bj = 0; bj < 2; ++bj) { const f32x4 v0 = acc[ai][bj][m][0], v1 = acc[ai][bj][m][1];
                    u32x4 w; w.x = cvt_pk_bf16(v0[0], v0[1]); w.y = cvt_pk_bf16(v0[2], v0[3]); w.z = cvt_pk_bf16(v1[0], v1[1]); w.w = cvt_pk_bf16(v1[2], v1[3]);
                    __builtin_nontemporal_store(w, (u32x4*)(rowp + bj * HALF)); } }
    }
};
}

struct Args {
    const float* x; const float* a_w_in; const float* a_ln_g; const float* a_ln_b; const float* a_w_s; const float* a_b_s; const float* a_w_out;
    const float* a_pre_g; const float* a_post_g; const float* kv_norm_g; const float* w_k; const float* w_v; const float* b_w_in; const float* b_sinks;
    const float* b_w_out; const float* b_pre_g; const float* b_post_g;
    float* out; unsigned char* ws;
};

__device__ __forceinline__ void transpose_item(const float* W, int ldw, int col0, int K, bf16* WT, int row_off, int nblk, const float* gv, float mult, LAS float* scr, int item, int lane) {
    const int kb = item / nblk, nb = item % nblk, k0 = 64 * kb, n0 = 32 * nb;
    float wv[32], gg[32];
#pragma unroll
    for (int i = 0; i < 32; ++i) { const int kk = 2 * i + (lane >> 5); wv[i] = W[(size_t)(k0 + kk) * ldw + col0 + n0 + (lane & 31)]; gg[i] = gv ? gv[k0 + kk] : 1.0f; }
#pragma unroll
    for (int i = 0; i < 32; ++i) { const int kk = 2 * i + (lane >> 5); scr[kk * 33 + (lane & 31)] = wv[i] * (gg[i] * mult); }
    asm volatile("s_waitcnt lgkmcnt(0)" ::: "memory");
    const int c = lane & 7;
#pragma unroll
    for (int j = 0; j < 4; ++j) { const int n = (lane >> 3) + 8 * j; const LAS float* s = scr + (8 * c) * 33 + n;
        v4u o; o.x = pk2(s[0 * 33], s[1 * 33]); o.y = pk2(s[2 * 33], s[3 * 33]); o.z = pk2(s[4 * 33], s[5 * 33]); o.w = pk2(s[6 * 33], s[7 * 33]);
        *(v4u*)(WT + (size_t)(row_off + n0 + n) * K + k0 + 8 * c) = o; }
    asm volatile("s_waitcnt lgkmcnt(0)" ::: "memory");
}

__device__ __forceinline__ void p0_prologue(const Args& a, LAS unsigned char* lds, int gw, int NGW, int wave, int lane) {
    LAS float* scr = (LAS float*)(lds + wave * 16384);
    bf16* ws_wa_in = (bf16*)(a.ws + WS_WA_IN); bf16* ws_wa_out = (bf16*)(a.ws + WS_WA_OUT);
    bf16* ws_wb_in0 = (bf16*)(a.ws + WS_WB_IN0); bf16* ws_wb_in1 = (bf16*)(a.ws + WS_WB_IN1); bf16* ws_wb_out = (bf16*)(a.ws + WS_WB_OUT);
    constexpr int I_AIN = 16 * 64;
    constexpr int I_AOUT = 32 * 32;
    constexpr int I_BIN = 16 * 32;
    constexpr int I_KV = 16 * 8;
    constexpr int I_BOUT = 16 * 32;
    constexpr int NITEMS = 6 * I_AIN + 2 * I_AOUT + 4 * I_BIN + 2 * I_KV + 2 * I_BOUT;
    for (int it = gw; it < NITEMS; it += NGW) {
        int r = it;
        if (r < 6 * I_AIN) { const int l = r / (3 * I_AIN), part = (r / I_AIN) % 3, item = r % I_AIN;
            const int col0 = part == 0 ? 0 : (part == 1 ? 4096 : 2048);
            transpose_item(a.a_w_in + (size_t)l * 1024 * 6144, 6144, col0, 1024, ws_wa_in + (size_t)l * 6144 * 1024, part * 2048, 64, a.a_pre_g + l * 1024, 1.0f, scr, item, lane); continue; }
        r -= 6 * I_AIN;
        if (r < 2 * I_AOUT) { const int l = r / I_AOUT, item = r % I_AOUT;
            transpose_item(a.a_w_out + (size_t)l * 2048 * 1024, 1024, 0, 2048, ws_wa_out + (size_t)l * 1024 * 2048, 0, 32, nullptr, 1.0f, scr, item, lane); continue; }
        r -= 2 * I_AOUT;
        if (r < 4 * I_BIN) { const int l = r / (2 * I_BIN), part = (r / I_BIN) & 1, item = r % I_BIN;
            transpose_item(a.b_w_in + (size_t)l * 1024 * 2048, 2048, part * 1024, 1024, l ? ws_wb_in1 : ws_wb_in0, part * 1024, 32, a.b_pre_g + l * 1024, part == 0 ? 0.125f : 1.0f, scr, item, lane); continue; }
        r -= 4 * I_BIN;
        if (r < 2 * I_KV) { const int part = r / I_KV, item = r % I_KV;
            transpose_item(part ? a.w_v : a.w_k, 256, 0, 1024, ws_wb_in0, 2048 + part * 256, 8, a.kv_norm_g, 1.0f, scr, item, lane); continue; }
        r -= 2 * I_KV;
        { const int l = r / I_BOUT, item = r % I_BOUT;
            transpose_item(a.b_w_out + (size_t)l * 1024 * 1024, 1024, 0, 1024, ws_wb_out + (size_t)l * 1024 * 1024, 0, 32, nullptr, 1.0f, scr, item, lane); }
    }
    { bf16* W16 = (bf16*)(a.ws + WS_W16); const int gt = gw * 64 + lane, NT = NGW * 64;
      for (int i = gt; i < 2 * 8 * 128 * 16; i += NT) { const int t = (i >> 4) & 127, s = (i & 15) * 8; const float* src = a.a_w_s + (size_t)i * 8;
          const f32x4 w0 = *(const f32x4*)src, w1 = *(const f32x4*)(src + 4); v4u o;
          o.x = pk2(s + 0 <= t ? w0.x : 0.f, s + 1 <= t ? w0.y : 0.f); o.y = pk2(s + 2 <= t ? w0.z : 0.f, s + 3 <= t ? w0.w : 0.f);
          o.z = pk2(s + 4 <= t ? w1.x : 0.f, s + 5 <= t ? w1.y : 0.f); o.w = pk2(s + 6 <= t ? w1.z : 0.f, s + 7 <= t ? w1.w : 0.f);
          *(v4u*)(W16 + (size_t)i * 8) = o; } }
    bf16* HN = (bf16*)(a.ws + WS_HN); float* RINV = (float*)(a.ws + WS_RINV);
    for (int mb = gw * 4; mb < M; mb += NGW * 4) {
        f32x4 v[4][4];
#pragma unroll
        for (int r = 0; r < 4; ++r) { const f32x4* xr = (const f32x4*)(a.x + (size_t)(mb + r) * D) + lane;
#pragma unroll
            for (int j = 0; j < 4; ++j) v[r][j] = xr[64 * j]; }
#pragma unroll
        for (int r = 0; r < 4; ++r) { v2u o[4]; float s = 0.f;
#pragma unroll
            for (int j = 0; j < 4; ++j) { o[j].x = pk2(v[r][j].x, v[r][j].y); o[j].y = pk2(v[r][j].z, v[r][j].w);
                const float a0 = bflo(o[j].x), a1 = bfhi(o[j].x), a2 = bflo(o[j].y), a3 = bfhi(o[j].y); s += (a0 * a0 + a1 * a1) + (a2 * a2 + a3 * a3); }
            const float rr = __builtin_amdgcn_rsqf(wave_sum(s) * (1.f / D) + EPS);
            v2u* o8 = (v2u*)(HN + (size_t)(mb + r) * D) + lane;
#pragma unroll
            for (int j = 0; j < 4; ++j) o8[64 * j] = o[j];
            if (lane == 0) RINV[mb + r] = rr; }
    }
}

__device__ __forceinline__ void row_phase(const bf16* Y, bf16* H, const float* post_g, float* RINV, float* out_final, int gw, int NGW, int lane) {
    f32x4 g[4];
#pragma unroll
    for (int j = 0; j < 4; ++j) g[j] = ((const f32x4*)post_g)[lane + 64 * j];
    for (int mb = gw * 4; mb < M; mb += NGW * 4) {
        v2u yw[4][4], hw[4][4];
#pragma unroll
        for (int r = 0; r < 4; ++r) { const v2u* yr = (const v2u*)(Y + (size_t)(mb + r) * D) + lane; const v2u* hr = (const v2u*)(H + (size_t)(mb + r) * D) + lane;
#pragma unroll
            for (int j = 0; j < 4; ++j) { yw[r][j] = yr[64 * j]; hw[r][j] = hr[64 * j]; } }
#pragma unroll
        for (int r = 0; r < 4; ++r) { const int m = mb + r;
            f32x4 y[4]; float s = 0.f;
#pragma unroll
            for (int j = 0; j < 4; ++j) { y[j] = (f32x4){bflo(yw[r][j].x), bfhi(yw[r][j].x), bflo(yw[r][j].y), bfhi(yw[r][j].y)}; s += (y[j].x * y[j].x + y[j].y * y[j].y) + (y[j].z * y[j].z + y[j].w * y[j].w); }
            const float r1 = __builtin_amdgcn_rsqf(wave_sum(s) * (1.f / D) + EPS);
            if (out_final) {
                f32x4* ho = (f32x4*)(out_final + (size_t)m * D) + lane;
#pragma unroll
                for (int j = 0; j < 4; ++j) { const f32x4 h = (f32x4){bflo(hw[r][j].x), bfhi(hw[r][j].x), bflo(hw[r][j].y), bfhi(hw[r][j].y)}; ho[64 * j] = h + y[j] * r1 * g[j]; }
            } else {
                float s2 = 0.f; v2u* hr = (v2u*)(H + (size_t)m * D) + lane;
#pragma unroll
                for (int j = 0; j < 4; ++j) { const f32x4 h = (f32x4){bflo(hw[r][j].x), bfhi(hw[r][j].x), bflo(hw[r][j].y), bfhi(hw[r][j].y)}; const f32x4 hn = h + y[j] * r1 * g[j];
                    v2u o; o.x = pk2(hn.x, hn.y); o.y = pk2(hn.z, hn.w); hr[64 * j] = o;
                    const float a0 = bflo(o.x), a1 = bfhi(o.x), a2 = bflo(o.y), a3 = bfhi(o.y); s2 += (a0 * a0 + a1 * a1) + (a2 * a2 + a3 * a3); }
                const float r2 = __builtin_amdgcn_rsqf(wave_sum(s2) * (1.f / D) + EPS);
                if (lane == 0) RINV[m] = r2;
            }
        }
    }
}

constexpr int WL_STRIDE = 136;
constexpr int GATE_MAXCH = 32;
__device__ __forceinline__ void gate_phase(const Args& a, int layer, LAS unsigned char* lds, int G, int tid, int wave, int lane) {
    LAS bf16* Wl = (LAS bf16*)lds;
    LAS float* mu_l = (LAS float*)(lds + 128 * WL_STRIDE * 2);
    LAS float* rs_l = mu_l + GATE_MAXCH * 128;
    bf16* U = (bf16*)(a.ws + WS_U); const bf16* Z = (const bf16*)(a.ws + WS_Z); const bf16* VT = (const bf16*)(a.ws + WS_VT);
    const float* ssum = (const float*)(a.ws + WS_STAT); const float* ssq = ssum + (size_t)16 * M;
    const int fr = lane & 15, fq = lane >> 4;
    const int g = blockIdx.x & 7, c0 = blockIdx.x >> 3, cstep = G >> 3;
    {
        const int t = tid >> 2, s0 = (tid & 3) * 32; const float* wsrc = a.a_w_s + (((size_t)layer * 8 + g) * CH + t) * CH + s0;
#pragma unroll
        for (int j = 0; j < 4; ++j) { const f32x4 w0 = *(const f32x4*)(wsrc + 8 * j), w1 = *(const f32x4*)(wsrc + 8 * j + 4); const int s = s0 + 8 * j;
            v4u o; o.x = pk2(s + 0 <= t ? w0.x : 0.f, s + 1 <= t ? w0.y : 0.f); o.y = pk2(s + 2 <= t ? w0.z : 0.f, s + 3 <= t ? w0.w : 0.f);
            o.z = pk2(s + 4 <= t ? w1.x : 0.f, s + 5 <= t ? w1.y : 0.f); o.w = pk2(s + 6 <= t ? w1.z : 0.f, s + 7 <= t ? w1.w : 0.f);
            *(LAS v4u*)(Wl + t * WL_STRIDE + s) = o; }
    }
    {
        int ci = 0;
        for (int chunk = c0; chunk < 512; chunk += cstep, ++ci) {
            if (tid < CH) { const size_t tok = (size_t)chunk * CH + tid; float s = 0.f, q = 0.f;
#pragma unroll
                for (int k = 0; k < 16; ++k) { s += ssum[(size_t)k * M + tok]; q += ssq[(size_t)k * M + tok]; }
                const float mu = s * (1.f / AW); const float var = fmaxf(q * (1.f / AW) - mu * mu, 0.f);
                mu_l[ci * 128 + tid] = mu; rs_l[ci * 128 + tid] = __builtin_amdgcn_rsqf(var + EPS); }
        }
    }
    __syncthreads();
    const int cb = g * 256 + wave * 32;
    float lg[2], lb[2];
#pragma unroll
    for (int n = 0; n < 2; ++n) { const int ch = cb + 8 * (fr >> 2) + 4 * n + (fr & 3); lg[n] = a.a_ln_g[layer * AW + ch]; lb[n] = a.a_ln_b[layer * AW + ch]; }
    const float* bsrc = a.a_b_s + ((size_t)layer * 8 + g) * CH;
    float bs[8];
#pragma unroll
    for (int mb = 0; mb < 8; ++mb) bs[mb] = bsrc[16 * mb + fr];
    int ci = 0;
    for (int chunk = c0; chunk < 512; chunk += cstep, ++ci) {
        const size_t tok0 = (size_t)chunk * CH;
        v4u raw[2][4], u8[8], z8[8];
#pragma unroll
        for (int n = 0; n < 2; ++n) { const int ch = cb + 8 * (fr >> 2) + 4 * n + (fr & 3);
#pragma unroll
            for (int k = 0; k < 4; ++k) raw[n][k] = *(const v4u*)(VT + ((size_t)chunk * AW + ch) * 128 + 32 * k + 8 * fq); }
#pragma unroll
        for (int mb = 0; mb < 8; ++mb) { const size_t off = (tok0 + 16 * mb + fr) * AW + cb + 8 * fq; u8[mb] = *(const v4u*)(U + off); z8[mb] = *(const v4u*)(Z + off); }
        bf16x8 bfr[2][4];
#pragma unroll
        for (int k = 0; k < 4; ++k) { const int s = 32 * k + 8 * fq;
            const f32x4 m0 = *(LAS f32x4*)(mu_l + ci * 128 + s), m1 = *(LAS f32x4*)(mu_l + ci * 128 + s + 4), r0 = *(LAS f32x4*)(rs_l + ci * 128 + s), r1 = *(LAS f32x4*)(rs_l + ci * 128 + s + 4);
#pragma unroll
            for (int n = 0; n < 2; ++n) { const v4u rw = raw[n][k]; const float g_ = lg[n], b_ = lb[n];
                v4u o;
                o.x = pk2((bflo(rw.x) - m0.x) * r0.x * g_ + b_, (bfhi(rw.x) - m0.y) * r0.y * g_ + b_);
                o.y = pk2((bflo(rw.y) - m0.z) * r0.z * g_ + b_, (bfhi(rw.y) - m0.w) * r0.w * g_ + b_);
                o.z = pk2((bflo(rw.z) - m1.x) * r1.x * g_ + b_, (bfhi(rw.z) - m1.y) * r1.y * g_ + b_);
                o.w = pk2((bflo(rw.w) - m1.z) * r1.z * g_ + b_, (bfhi(rw.w) - m1.w) * r1.w * g_ + b_);
                bfr[n][k] = __builtin_bit_cast(bf16x8, o); } }
#pragma unroll
        for (int mb = 0; mb < 8; ++mb) {
            f32x4 acc0 = (f32x4){0.f, 0.f, 0.f, 0.f}, acc1 = (f32x4){0.f, 0.f, 0.f, 0.f};
            const int t = 16 * mb + fr;
#pragma unroll
            for (int k = 0; k < 4; ++k) { if (k <= (mb >> 1)) {
                const bf16x8 af = *(LAS bf16x8*)(Wl + t * WL_STRIDE + 32 * k + 8 * fq);
                acc0 = __builtin_amdgcn_mfma_f32_16x16x32_bf16(bfr[0][k], af, acc0, 0, 0, 0);
                acc1 = __builtin_amdgcn_mfma_f32_16x16x32_bf16(bfr[1][k], af, acc1, 0, 0, 0); } }
            const v4u uu = u8[mb], zz = z8[mb]; const float b_ = bs[mb];
            v4u o;
            o.x = pk2(bflo(uu.x) * (acc0.x + b_) * bflo(zz.x), bfhi(uu.x) * (acc0.y + b_) * bfhi(zz.x));
            o.y = pk2(bflo(uu.y) * (acc0.z + b_) * bflo(zz.y), bfhi(uu.y) * (acc0.w + b_) * bfhi(zz.y));
            o.z = pk2(bflo(uu.z) * (acc1.x + b_) * bflo(zz.z), bfhi(uu.z) * (acc1.y + b_) * bfhi(zz.z));
            o.w = pk2(bflo(uu.w) * (acc1.z + b_) * bflo(zz.w), bfhi(uu.w) * (acc1.w + b_) * bfhi(zz.w));
            *(v4u*)(U + (tok0 + t) * AW + cb + 8 * fq) = o;
        }
    }
    __syncthreads();
}

constexpr int AT_KSTR = 144, AT_VSTR = 528, AT_VOFF = 256 * AT_KSTR;
__device__ __forceinline__ void attn_load_tiles(const bf16* KB, const bf16* VTB, int it, int tid, v4u (&kr)[4], v4u (&vr)[4]) {
    const int kvh = it & 3, qi = (it >> 2) & 31, b = it >> 7;
    const long tokb = (long)b * SEQ + (long)qi * 128; const int gb = b * 32 + qi;
#pragma unroll
    for (int j = 0; j < 4; ++j) { const int c = tid + 512 * j;
        { const int row = c >> 3, part = c & 7;
          kr[j] = (qi == 0 && row < 128) ? (v4u){0u, 0u, 0u, 0u} : *(const v4u*)(KB + (size_t)(tokb - 128 + row) * 256 + kvh * 64 + part * 8); }
        { const int dd = c >> 5, half = (c >> 4) & 1, part = c & 15;
          vr[j] = (qi == 0 && half == 0) ? (v4u){0u, 0u, 0u, 0u} : *(const v4u*)(VTB + ((size_t)(gb - 1 + half) * 256 + kvh * 64 + dd) * 128 + part * 8); } }
}
__device__ __forceinline__ void attn_phase(const Args& a, int layer, LAS unsigned char* lds, int G, int tid, int wave, int lane) {
    bf16* Q = (bf16*)(a.ws + WS_U); const bf16* ZG = Q + (size_t)M * D;
    const bf16* KB = (const bf16*)(a.ws + WS_Z); const bf16* VTB = KB + (size_t)M * 256;
    const int fr = lane & 15, fq = lane >> 4;
    v4u kr[4], vr[4];
    if ((int)blockIdx.x < 2048) attn_load_tiles(KB, VTB, blockIdx.x, tid, kr, vr);
    for (int it = blockIdx.x; it < 2048; it += G) {
        const int kvh = it & 3, qi = (it >> 2) & 31, b = it >> 7;
        const int h = kvh * 4 + (wave >> 1);
        const float slope = __builtin_amdgcn_exp2f(-0.5f * (float)(h + 1)) * LOG2E;
        const float sink = a.b_sinks[layer * 16 + h] * LOG2E;
        const long tokb = (long)b * SEQ + (long)qi * 128;
        bf16x8 qf[4][2];
#pragma unroll
        for (int mb = 0; mb < 4; ++mb) { const size_t qrow = (size_t)(tokb + (wave & 1) * 64 + 16 * mb + fr) * D + h * 64;
            qf[mb][0] = *(const bf16x8*)(Q + qrow + 8 * fq); qf[mb][1] = *(const bf16x8*)(Q + qrow + 8 * fq + 32); }
        f32x4 bias0, bias8; const float b0 = -slope * (float)(128 + fr - 4 * fq);
#pragma unroll
        for (int e = 0; e < 4; ++e) { const int d0 = 128 + fr - 4 * fq - e, d8 = fr - 4 * fq - e; bias0[e] = d0 < 128 ? -slope * (float)d0 : -INFINITY; bias8[e] = d8 >= 0 ? -slope * (float)d8 : -INFINITY; }
        __syncthreads();
#pragma unroll
        for (int j = 0; j < 4; ++j) { const int c = tid + 512 * j;
            *(LAS v4u*)(lds + (c >> 3) * AT_KSTR + (c & 7) * 16) = kr[j];
            *(LAS v4u*)(lds + AT_VOFF + (c >> 5) * AT_VSTR + (((c >> 4) & 1) * 128 + (c & 15) * 8) * 2) = vr[j]; }
        __syncthreads();
        if (it + G < 2048) attn_load_tiles(KB, VTB, it + G, tid, kr, vr);
#pragma unroll
        for (int mb = 0; mb < 4; ++mb) {
            const int t0 = (wave & 1) * 64 + 16 * mb, nb0 = t0 >> 4;
            const size_t orow = (size_t)(tokb + t0 + fr) * D + h * 64 + 4 * fq;
            v2u zz[4];
#pragma unroll
            for (int db = 0; db < 4; ++db) zz[db] = *(const v2u*)(ZG + orow + 16 * db);
            f32x4 S[10]; v4u vfr[2][4];
            const LAS unsigned char* kbase = lds + (16 * nb0 + fr) * AT_KSTR + 16 * fq;
#pragma unroll
            for (int grp = 0; grp < 3; ++grp) {
                bf16x8 kfr[3][2];
#pragma unroll
                for (int j = 0; j < 3; ++j) { const int nb = 3 * grp + j; kfr[j][0] = *(const LAS bf16x8*)(kbase + nb * 16 * AT_KSTR); kfr[j][1] = *(const LAS bf16x8*)(kbase + nb * 16 * AT_KSTR + 64); }
                __builtin_amdgcn_sched_barrier(0);
#pragma unroll
                for (int j = 0; j < 3; ++j) { const int nb = 3 * grp + j; f32x4 z = (f32x4){0.f, 0.f, 0.f, 0.f};
                    z = __builtin_amdgcn_mfma_f32_16x16x32_bf16(kfr[j][0], qf[mb][0], z, 0, 0, 0);
                    S[nb] = __builtin_amdgcn_mfma_f32_16x16x32_bf16(kfr[j][1], qf[mb][1], z, 0, 0, 0); }
                __builtin_amdgcn_sched_barrier(0);
            }
            float mx = sink;
#pragma unroll
            for (int nb = 0; nb < 9; ++nb)
#pragma unroll
                for (int e = 0; e < 4; ++e) S[nb][e] = nb == 0 ? S[nb][e] * LOG2E + bias0[e] : (nb == 8 ? S[nb][e] * LOG2E + bias8[e] : (S[nb][e] * LOG2E + b0) + slope * (float)(16 * nb + e));
            if (qi == 0) {
#pragma unroll
                for (int nb = 0; nb < 9; ++nb)
#pragma unroll
                    for (int e = 0; e < 4; ++e) { const int c = 16 * (nb0 + nb) + 4 * fq + e; S[nb][e] = c >= 128 ? S[nb][e] : -INFINITY; }
            }
#pragma unroll
            for (int nb = 0; nb < 9; ++nb)
#pragma unroll
                for (int e = 0; e < 4; ++e) mx = fmaxf(mx, S[nb][e]);
            mx = fmaxf(mx, __shfl_xor(mx, 16)); mx = fmaxf(mx, __shfl_xor(mx, 32));
            float den = 0.f;
#pragma unroll
            for (int nb = 0; nb < 9; ++nb)
#pragma unroll
                for (int e = 0; e < 4; ++e) { const float p = __builtin_amdgcn_exp2f(S[nb][e] - mx); S[nb][e] = p; den += p; }
            den += __shfl_xor(den, 16); den += __shfl_xor(den, 32);
            den += __builtin_amdgcn_exp2f(sink - mx);
            S[9] = (f32x4){0.f, 0.f, 0.f, 0.f};
            f32x4 O[4];
#pragma unroll
            for (int db = 0; db < 4; ++db) O[db] = (f32x4){0.f, 0.f, 0.f, 0.f};
#define AT_LDV(buf, kk_) do { int kb0 = nb0 + 2 * (kk_), kb1 = kb0 + 1; if (kb0 > 15) kb0 = 15; if (kb1 > 15) kb1 = 15; \
                _Pragma("unroll") for (int db = 0; db < 4; ++db) { const LAS unsigned char* vp = lds + AT_VOFF + (16 * db + fr) * AT_VSTR + 8 * fq; \
                    const v2u v0 = *(const LAS v2u*)(vp + 32 * kb0), v1 = *(const LAS v2u*)(vp + 32 * kb1); vfr[buf][db].x = v0.x; vfr[buf][db].y = v0.y; vfr[buf][db].z = v1.x; vfr[buf][db].w = v1.y; } } while (0)
#define AT_PV(buf, kk_) do { v4u pw; pw.x = pk2(S[2 * (kk_)][0], S[2 * (kk_)][1]); pw.y = pk2(S[2 * (kk_)][2], S[2 * (kk_)][3]); pw.z = pk2(S[2 * (kk_) + 1][0], S[2 * (kk_) + 1][1]); pw.w = pk2(S[2 * (kk_) + 1][2], S[2 * (kk_) + 1][3]); \
                const bf16x8 pb = __builtin_bit_cast(bf16x8, pw); \
                _Pragma("unroll") for (int db = 0; db < 4; ++db) O[db] = __builtin_amdgcn_mfma_f32_16x16x32_bf16(__builtin_bit_cast(bf16x8, vfr[buf][db]), pb, O[db], 0, 0, 0); } while (0)
            AT_LDV(0, 0); AT_LDV(1, 1); AT_PV(0, 0);
            AT_LDV(0, 2); AT_PV(1, 1);
            AT_LDV(1, 3); AT_PV(0, 2);
            AT_LDV(0, 4); AT_PV(1, 3);
            AT_PV(0, 4);
#undef AT_LDV
#undef AT_PV
            const float inv = __builtin_amdgcn_rcpf(den);
#pragma unroll
            for (int db = 0; db < 4; ++db) {
                v2u o; o.x = pk2(O[db][0] * inv * bflo(zz[db].x), O[db][1] * inv * bfhi(zz[db].x)); o.y = pk2(O[db][2] * inv * bflo(zz[db].y), O[db][3] * inv * bfhi(zz[db].y));
                *(v2u*)(Q + orow + 16 * db) = o; }
        }
    }
    __syncthreads();
}

#define XB_TMO      128
#define XB_XCNT(j)  (256  + 64 * (j))
#define XB_XSUB(j)  (1280 + 64 * (j))
#define XB_XGEN(j)  (2304 + 64 * (j))
#define XB_TOP      3328
#define XB_TOPGEN   3392
#define XCD_BAR_WORDS 3456
#define XB_SPIN_CAP (1u << 18)

__device__ __forceinline__ unsigned xb_ld(unsigned* p)              { return __hip_atomic_load(p, __ATOMIC_RELAXED, __HIP_MEMORY_SCOPE_AGENT); }
__device__ __forceinline__ unsigned xb_add(unsigned* p, unsigned v) { return __hip_atomic_fetch_add(p, v, __ATOMIC_RELAXED, __HIP_MEMORY_SCOPE_AGENT); }
__device__ __forceinline__ unsigned xb_xcc_id() { return (unsigned)__builtin_amdgcn_s_getreg((3 << 11) | 20) & 0xFu; }
#define XB_SPIN(cond, bar) do { unsigned _sp = 0; while (cond) { __builtin_amdgcn_s_sleep(1); \
    if ((++_sp & 255u) == 0u) { if (xb_ld(&(bar)[XB_TMO])) break; if (_sp > XB_SPIN_CAP) { atomicAdd(&(bar)[XB_TMO], 1u); break; } } } } while (0)

struct XcdBarrier {
    unsigned* bar; unsigned x;
    volatile LAS unsigned* st;
};

__device__ __forceinline__ XcdBarrier xcd_barrier_post(unsigned* bar, volatile LAS unsigned* st) {
    XcdBarrier b; b.bar = bar; b.x = xb_xcc_id(); b.st = st;
    if (threadIdx.x == 0) (void)xb_add(&bar[XB_XCNT(b.x)], 1u);
    return b;
}
__device__ __forceinline__ void xcd_barrier_complete(unsigned* bar, unsigned x, unsigned& nloc, unsigned& nx) {
    const unsigned G = gridDim.x * gridDim.y * gridDim.z;
    unsigned sum, cnt, mine, sp = 0u;
    for (;;) {
        sum = 0u; cnt = 0u; mine = 0u;
#pragma unroll
        for (unsigned j = 0; j < 16; ++j) { const unsigned c = xb_ld(&bar[XB_XCNT(j)]); sum += c; cnt += (c > 0u) ? 1u : 0u; mine = (j == x) ? c : mine; }
        if (sum == G) break;
        __builtin_amdgcn_s_sleep(1);
        if ((++sp & 255u) == 0u) { if (xb_ld(&bar[XB_TMO])) break; if (sp > XB_SPIN_CAP) { atomicAdd(&bar[XB_TMO], 1u); break; } }
    }
    nloc = mine > 0u ? mine : 1u; nx = cnt > 0u ? cnt : 1u;
}

__device__ __forceinline__ void xcd_barrier(const XcdBarrier& b) {
    asm volatile("s_waitcnt vmcnt(0)" ::: "memory");
    __syncthreads();
    if (threadIdx.x == 0) {
        unsigned* bar = b.bar; asm volatile("" : "+s"(bar));
        __builtin_amdgcn_s_waitcnt(0);
        unsigned nloc = b.st[0], nx = b.st[1];
        if (nloc == 0u) { xcd_barrier_complete(bar, b.x, nloc, nx); b.st[0] = nloc; b.st[1] = nx; }
        const unsigned old = xb_add(&bar[XB_XSUB(b.x)], 1u);
        const unsigned gen = old / nloc;
        if (old + 1u == (gen + 1u) * nloc) {
            __builtin_amdgcn_fence(__ATOMIC_RELEASE, "agent");
            asm volatile("s_waitcnt vmcnt(0)" ::: "memory");
            const unsigned og = xb_add(&bar[XB_TOP], 1u);
            const unsigned tg = og / nx;
            if (og + 1u == (tg + 1u) * nx) xb_add(&bar[XB_TOPGEN], 1u);
            else XB_SPIN(xb_ld(&bar[XB_TOPGEN]) == tg, bar);
            __builtin_amdgcn_fence(__ATOMIC_ACQUIRE, "agent");
            xb_add(&bar[XB_XGEN(b.x)], 1u);
            asm volatile("s_waitcnt vmcnt(0)" ::: "memory");
        } else {
            XB_SPIN(xb_ld(&bar[XB_XGEN(b.x)]) == gen, bar);
            __builtin_amdgcn_fence(__ATOMIC_ACQUIRE, "agent");
            asm volatile("s_waitcnt vmcnt(0)" ::: "memory");
        }
    }
    __syncthreads();
}


__global__ void __launch_bounds__(NWAVES * 64, 2) yoco_fwd(Args a) {
    extern __shared__ __attribute__((aligned(16))) unsigned char lds_raw[];
    LAS unsigned char* lds = (LAS unsigned char*)lds_raw;
    cg::grid_group grid = cg::this_grid();
    if (threadIdx.x < 2) ((volatile LAS unsigned*)(lds + LDS_MISC))[threadIdx.x] = 0u;
    if (blockIdx.x == 0) { for (int i = threadIdx.x; i < XCD_BAR_WORDS; i += NWAVES * 64) ((unsigned*)a.ws + 4096)[i] = 0u; }
    __syncthreads();
#define GRID_BAR() xcd_barrier(xbar)
#define PHASE_IDS() int tid = threadIdx.x; asm volatile("" : "+v"(tid)); const int lane = tid & 63, wave = __builtin_amdgcn_readfirstlane(tid >> 6); const int gw = blockIdx.x * NWAVES + wave; (void)gw; (void)lane
    const int G = gridDim.x, NGW = G * NWAVES;
    bf16* HN = (bf16*)(a.ws + WS_HN);
    bf16* YOUT = (bf16*)(a.ws + WS_VT); float* RINV = (float*)(a.ws + WS_RINV);
#ifdef PROBE_A
    volatile LAS unsigned long long* tsl = (volatile LAS unsigned long long*)(lds + LDS_MISC + 64);
    int n_ts = 0;
#define STAMP() do { if (blockIdx.x == 0 && threadIdx.x == 0) tsl[n_ts] = __builtin_amdgcn_s_memrealtime(); ++n_ts; } while (0)
#else
#define STAMP() do {} while (0)
#endif
    STAMP();

    { PHASE_IDS(); p0_prologue(a, lds, gw, NGW, wave, lane); }
    grid.sync();
    const XcdBarrier xbar = xcd_barrier_post((unsigned*)a.ws + 4096, (volatile LAS unsigned*)(lds + LDS_MISC));
    STAMP();

    { constexpr int l = 0;
        const bf16* Win = (const bf16*)(a.ws + WS_WA_IN) + (size_t)l * 6144 * 1024;
        {
            pg8::Gemm g{HN, Win, M, AW, D}; pg8::StaticOrder S; S.init(M, AW, G, (int)blockIdx.x);
            pg8::EpiUZ E{(bf16*)(a.ws + WS_U), (bf16*)(a.ws + WS_Z), RINV};
            pg8::gemm_phase<pg8::EpiUZ, pg8::StaticOrder, true, true>(lds, g, S, E);
        }
        STAMP();
        {
            pg8::Gemm g{Win + (size_t)4096 * 1024, HN, AW, M, D}; pg8::StaticOrder S; S.init(AW, M, G, (int)blockIdx.x);
            pg8::EpiT<true> E{(bf16*)(a.ws + WS_VT), (float*)(a.ws + WS_STAT), (float*)(a.ws + WS_STAT) + (size_t)16 * M, AW, RINV};
            pg8::gemm_phase<pg8::EpiT<true>, pg8::StaticOrder, true, true>(lds, g, S, E);
        }
        GRID_BAR();
        STAMP();
        {
            PHASE_IDS(); const float* ssum = (const float*)(a.ws + WS_STAT); const float* ssq = ssum + (size_t)16 * M;
            for (int tok = blockIdx.x * 512 + tid; tok < M; tok += G * 512) { float s = 0.f, q = 0.f;
#pragma unroll
                for (int k = 0; k < 16; ++k) { s += ssum[(size_t)k * M + tok]; q += ssq[(size_t)k * M + tok]; }
                const float mu = s * (1.f / AW); const float var = fmaxf(q * (1.f / AW) - mu * mu, 0.f);
                const float rstd = __builtin_amdgcn_rsqf(var + EPS); ((float*)(a.ws + WS_MU))[tok] = -mu * rstd; ((float*)(a.ws + WS_RSTD))[tok] = rstd; }
        }
        GRID_BAR();
        {
            pg8::GroupOrder S{(int)blockIdx.x, G};
            {
                PHASE_IDS(); const int g = ((int)blockIdx.x >> 3) & 7; const bf16* W16 = (const bf16*)(a.ws + WS_W16) + ((size_t)l * 8 + g) * 128 * 128;
                for (int c = tid; c < 20 * 64; c += 512) { const int f = c >> 6, r = (c >> 2) & 15, part = c & 3;
                    int m8 = 0, fb = 0;
#pragma unroll
                    for (int j = 1; j < 8; ++j) { const int b = ((j >> 1) + 1) * ((j >> 1) + (j & 1)); if (f >= b) { m8 = j; fb = b; } }
                    const int k = f - fb;
                    *(LAS v4u*)(lds + LDS_WL + f * 1280 + r * 80 + part * 16) = *(const v4u*)(W16 + (size_t)(16 * m8 + r) * 128 + 32 * k + 8 * part); }
                { pg8::Unit u0; S.next(0, u0); ((LAS float*)(lds + LDS_ST))[tid] = ((const float*)(a.ws + (tid < 256 ? WS_MU : WS_RSTD)))[(size_t)u0.pm * 256 + (tid & 255)]; }
                __syncthreads();
            }
            pg8::Gemm g{HN, Win + (size_t)2048 * 1024, M, AW, D};
            pg8::EpiZGate E{(bf16*)(a.ws + WS_U), (const bf16*)(a.ws + WS_VT), RINV, (const float*)(a.ws + WS_MU), (const float*)(a.ws + WS_RSTD),
                            a.a_ln_g + l * AW, a.a_ln_b + l * AW, a.a_b_s + l * 8 * 128, lds + LDS_WL, lds + LDS_ST, (int)(blockIdx.x >> 6), G >> 6};
            pg8::gemm_phase<pg8::EpiZGate, pg8::GroupOrder, true, true>(lds, g, S, E);
        }
        GRID_BAR();
        STAMP();
        {
            pg8::Gemm g{(const bf16*)(a.ws + WS_U), (const bf16*)(a.ws + WS_WA_OUT) + (size_t)l * 1024 * 2048, M, D, AW}; pg8::StaticOrder S; S.init(M, D, G, (int)blockIdx.x);
            pg8::EpiY16 E{YOUT, D};
            pg8::gemm_phase<pg8::EpiY16, pg8::StaticOrder, true, true>(lds, g, S, E);
        }
        GRID_BAR();
        STAMP();
        { PHASE_IDS(); row_phase(YOUT, HN, a.a_post_g + l * D, RINV, nullptr, gw, NGW, lane); }
        GRID_BAR();
        STAMP();
    }
    { constexpr int l = 1;
        const bf16* Win = (const bf16*)(a.ws + WS_WA_IN) + (size_t)l * 6144 * 1024;
        {
            pg8::Gemm g{HN, Win, M, AW, D}; pg8::StaticOrder S; S.init(M, AW, G, (int)blockIdx.x);
            pg8::EpiUZ E{(bf16*)(a.ws + WS_U), (bf16*)(a.ws + WS_Z), RINV};
            pg8::gemm_phase<pg8::EpiUZ, pg8::StaticOrder, true, true>(lds, g, S, E);
        }
        STAMP();
        {
            pg8::Gemm g{Win + (size_t)4096 * 1024, HN, AW, M, D}; pg8::StaticOrder S; S.init(AW, M, G, (int)blockIdx.x);
            pg8::EpiT<true> E{(bf16*)(a.ws + WS_VT), (float*)(a.ws + WS_STAT), (float*)(a.ws + WS_STAT) + (size_t)16 * M, AW, RINV};
            pg8::gemm_phase<pg8::EpiT<true>, pg8::StaticOrder, true, true>(lds, g, S, E);
        }
        GRID_BAR();
        STAMP();
        {
            PHASE_IDS(); const float* ssum = (const float*)(a.ws + WS_STAT); const float* ssq = ssum + (size_t)16 * M;
            for (int tok = blockIdx.x * 512 + tid; tok < M; tok += G * 512) { float s = 0.f, q = 0.f;
#pragma unroll
                for (int k = 0; k < 16; ++k) { s += ssum[(size_t)k * M + tok]; q += ssq[(size_t)k * M + tok]; }
                const float mu = s * (1.f / AW); const float var = fmaxf(q * (1.f / AW) - mu * mu, 0.f);
                const float rstd = __builtin_amdgcn_rsqf(var + EPS); ((float*)(a.ws + WS_MU))[tok] = -mu * rstd; ((float*)(a.ws + WS_RSTD))[tok] = rstd; }
        }
        GRID_BAR();
        {
            pg8::GroupOrder S{(int)blockIdx.x, G};
            {
                PHASE_IDS(); const int g = ((int)blockIdx.x >> 3) & 7; const bf16* W16 = (const bf16*)(a.ws + WS_W16) + ((size_t)l * 8 + g) * 128 * 128;
                for (int c = tid; c < 20 * 64; c += 512) { const int f = c >> 6, r = (c >> 2) & 15, part = c & 3;
                    int m8 = 0, fb = 0;
#pragma unroll
                    for (int j = 1; j < 8; ++j) { const int b = ((j >> 1) + 1) * ((j >> 1) + (j & 1)); if (f >= b) { m8 = j; fb = b; } }
                    const int k = f - fb;
                    *(LAS v4u*)(lds + LDS_WL + f * 1280 + r * 80 + part * 16) = *(const v4u*)(W16 + (size_t)(16 * m8 + r) * 128 + 32 * k + 8 * part); }
                { pg8::Unit u0; S.next(0, u0); ((LAS float*)(lds + LDS_ST))[tid] = ((const float*)(a.ws + (tid < 256 ? WS_MU : WS_RSTD)))[(size_t)u0.pm * 256 + (tid & 255)]; }
                __syncthreads();
            }
            pg8::Gemm g{HN, Win + (size_t)2048 * 1024, M, AW, D};
            pg8::EpiZGate E{(bf16*)(a.ws + WS_U), (const bf16*)(a.ws + WS_VT), RINV, (const float*)(a.ws + WS_MU), (const float*)(a.ws + WS_RSTD),
                            a.a_ln_g + l * AW, a.a_ln_b + l * AW, a.a_b_s + l * 8 * 128, lds + LDS_WL, lds + LDS_ST, (int)(blockIdx.x >> 6), G >> 6};
            pg8::gemm_phase<pg8::EpiZGate, pg8::GroupOrder, true, true>(lds, g, S, E);
        }
        GRID_BAR();
        STAMP();
        {
            pg8::Gemm g{(const bf16*)(a.ws + WS_U), (const bf16*)(a.ws + WS_WA_OUT) + (size_t)l * 1024 * 2048, M, D, AW}; pg8::StaticOrder S; S.init(M, D, G, (int)blockIdx.x);
            pg8::EpiY16 E{YOUT, D};
            pg8::gemm_phase<pg8::EpiY16, pg8::StaticOrder, true, true>(lds, g, S, E);
        }
        GRID_BAR();
        STAMP();
        { PHASE_IDS(); row_phase(YOUT, HN, a.a_post_g + l * D, RINV, nullptr, gw, NGW, lane); }
        GRID_BAR();
        STAMP();
    }
    { constexpr int l = 0;
        const bf16* Win = (const bf16*)(a.ws + (l ? WS_WB_IN1 : WS_WB_IN0));
        bf16* Q = (bf16*)(a.ws + WS_U); bf16* ZG = Q + (size_t)M * D; bf16* KB = (bf16*)(a.ws + WS_Z); bf16* VTB = KB + (size_t)M * 256;
        {
            const int N = l ? 2048 : 2304;
            pg8::Gemm g{HN, Win, M, N, D}; pg8::StaticOrder S; S.init(M, N, G, (int)blockIdx.x);
            pg8::EpiBin E{a.ws, RINV};
            pg8::gemm_phase<pg8::EpiBin, pg8::StaticOrder, true, true>(lds, g, S, E);
        }
        STAMP();
        if (l == 0) {
            pg8::Gemm g{Win + (size_t)2304 * 1024, HN, 256, M, D}; pg8::StaticOrder S; S.init(256, M, G, (int)blockIdx.x);
            pg8::EpiT<false> E{VTB, nullptr, nullptr, 256, RINV};
            pg8::gemm_phase<pg8::EpiT<false>, pg8::StaticOrder, true, true>(lds, g, S, E);
        }
        GRID_BAR();
        STAMP();
        { PHASE_IDS(); attn_phase(a, l, lds, G, tid, wave, lane); }
        GRID_BAR();
        STAMP();
        {
            pg8::Gemm g{Q, (const bf16*)(a.ws + WS_WB_OUT) + (size_t)l * 1024 * 1024, M, D, D}; pg8::StaticOrder S; S.init(M, D, G, (int)blockIdx.x);
            pg8::EpiY16 E{YOUT, D};
            pg8::gemm_phase<pg8::EpiY16, pg8::StaticOrder, true, true>(lds, g, S, E);
        }
        GRID_BAR();
        STAMP();
        { PHASE_IDS(); row_phase(YOUT, HN, a.b_post_g + l * D, RINV, l == 0 ? nullptr : a.out, gw, NGW, lane); }
        if (l == 0) GRID_BAR();
        STAMP();
    }
    { constexpr int l = 1;
        const bf16* Win = (const bf16*)(a.ws + (l ? WS_WB_IN1 : WS_WB_IN0));
        bf16* Q = (bf16*)(a.ws + WS_U); bf16* ZG = Q + (size_t)M * D; bf16* KB = (bf16*)(a.ws + WS_Z); bf16* VTB = KB + (size_t)M * 256;
        {
            const int N = l ? 2048 : 2304;
            pg8::Gemm g{HN, Win, M, N, D}; pg8::StaticOrder S; S.init(M, N, G, (int)blockIdx.x);
            pg8::EpiBin E{a.ws, RINV};
            pg8::gemm_phase<pg8::EpiBin, pg8::StaticOrder, true, true>(lds, g, S, E);
        }
        STAMP();
        if (l == 0) {
            pg8::Gemm g{Win + (size_t)2304 * 1024, HN, 256, M, D}; pg8::StaticOrder S; S.init(256, M, G, (int)blockIdx.x);
            pg8::EpiT<false> E{VTB, nullptr, nullptr, 256, RINV};
            pg8::gemm_phase<pg8::EpiT<false>, pg8::StaticOrder, true, true>(lds, g, S, E);
        }
        GRID_BAR();
        STAMP();
        { PHASE_IDS(); attn_phase(a, l, lds, G, tid, wave, lane); }
        GRID_BAR();
        STAMP();
        {
            pg8::Gemm g{Q, (const bf16*)(a.ws + WS_WB_OUT) + (size_t)l * 1024 * 1024, M, D, D}; pg8::StaticOrder S; S.init(M, D, G, (int)blockIdx.x);
            pg8::EpiY16 E{YOUT, D};
            pg8::gemm_phase<pg8::EpiY16, pg8::StaticOrder, true, true>(lds, g, S, E);
        }
        GRID_BAR();
        STAMP();
        { PHASE_IDS(); row_phase(YOUT, HN, a.b_post_g + l * D, RINV, l == 0 ? nullptr : a.out, gw, NGW, lane); }
        if (l == 0) GRID_BAR();
        STAMP();
    }
#ifdef PROBE_A
    if (blockIdx.x == 0 && threadIdx.x < 64) {
        asm volatile("s_waitcnt vmcnt(0) lgkmcnt(0)" ::: "memory");
#ifdef PROBE_CONST
        int n = PROBE_CONST;
#else
        int n = (int)((tsl[PROBE_B] - tsl[PROBE_A]) / 100ull);
#endif
        n = n < 0 ? 0 : (n > 16384 ? 16384 : n);
#ifdef PROBE_BIG
        if (threadIdx.x == 0) a.out[0] = 1000.0f * (float)n;
        n = 0;
#endif
        for (int idx = threadIdx.x; idx < n; idx += 64) { float* p = a.out + ((size_t)(idx >> 12) * NGW * 4 + ((idx >> 10) & 3)) * D + (idx & 1023); *p = *p + 0.25f; }
    }
#endif
}

extern "C" void kernel_launch(void* const* d_in, const int* in_sizes, int n_in, void* d_out, int out_size, void* d_ws, size_t ws_size, hipStream_t stream) {
    static int grid = 0;
    if (grid == 0) {
        if (n_in != 17 || in_sizes[0] != M * D || out_size != M * D || ws_size < WS_END) { fprintf(stderr, "kernel_launch: unexpected shapes (n_in %d, in0 %d, out %d, ws %zu)\n", n_in, n_in > 0 ? in_sizes[0] : -1, out_size, ws_size); grid = -1; return; }
        int dev = 0, cus = 0, per_cu = 0;
        hipGetDevice(&dev); hipDeviceGetAttribute(&cus, hipDeviceAttributeMultiprocessorCount, dev);
        if (hipFuncSetAttribute((const void*)yoco_fwd, hipFuncAttributeMaxDynamicSharedMemorySize, LDS_BYTES) != hipSuccess) { fprintf(stderr, "kernel_launch: hipFuncSetAttribute failed\n"); grid = -1; return; }
        if (hipOccupancyMaxActiveBlocksPerMultiprocessor(&per_cu, (const void*)yoco_fwd, NWAVES * 64, LDS_BYTES) != hipSuccess || per_cu < 1) { fprintf(stderr, "kernel_launch: occupancy query says %d\n", per_cu); per_cu = 1; }
        (void)hipGetLastError();
        grid = cus;
        if (grid % 64 != 0) { fprintf(stderr, "kernel_launch: %d CUs; this kernel's unit orders need a multiple of 64\n", cus); grid = -1; return; }
    }
    if (grid < 0) return;
    Args a{};
    a.x = (const float*)d_in[0]; a.a_w_in = (const float*)d_in[1]; a.a_ln_g = (const float*)d_in[2]; a.a_ln_b = (const float*)d_in[3]; a.a_w_s = (const float*)d_in[4];
    a.a_b_s = (const float*)d_in[5]; a.a_w_out = (const float*)d_in[6]; a.a_pre_g = (const float*)d_in[7]; a.a_post_g = (const float*)d_in[8]; a.kv_norm_g = (const float*)d_in[9];
    a.w_k = (const float*)d_in[10]; a.w_v = (const float*)d_in[11]; a.b_w_in = (const float*)d_in[12]; a.b_sinks = (const float*)d_in[13]; a.b_w_out = (const float*)d_in[14];
    a.b_pre_g = (const float*)d_in[15]; a.b_post_g = (const float*)d_in[16];
    a.out = (float*)d_out; a.ws = (unsigned char*)d_ws;
    void* args[] = {&a};
    hipError_t e = hipLaunchCooperativeKernel((const void*)yoco_fwd, dim3(grid), dim3(NWAVES * 64), args, LDS_BYTES, stream);
    if (e != hipSuccess) fprintf(stderr, "kernel_launch: cooperative launch failed: %s (grid %d)\n", hipGetErrorString(e), grid);
}
```
